# Optimizing an MI355X kernel written in HIP

```python
import math
import jax, jax.numpy as jnp
from jax import lax
import numpy as np

D_MODEL = 1024
BATCH = 4
SEQ = 8192
DEPTH = 2

HEAD_DIM = 64
N_HEADS = 16
D_MIX = N_HEADS * HEAD_DIM
N_HEADS_A = 8
N_KV_A = 2
WINDOW = 128
N_HEADS_B = 4
MOBA_BLOCK = 256
MOBA_TOPK = 3
N_HEADS_C = 4
C_KV_LATENT = 128
N_IDX_HEADS = 4
IDX_DIM = 64
DSA_TOPK = 256
D_FF = 2816
N_BUCKETS = 32
MAX_DISTANCE = 128
RMS_EPS = 1e-6
Q_BLOCK = 128

A_Q = N_HEADS_A * HEAD_DIM
A_KV = N_KV_A * HEAD_DIM
B_QKV = N_HEADS_B * HEAD_DIM
C_Q = N_HEADS_C * HEAD_DIM
C_QIDX = N_IDX_HEADS * IDX_DIM
COL_SIZES = (A_Q, A_KV, A_KV, B_QKV, B_QKV, B_QKV, C_Q, C_KV_LATENT, C_QIDX, IDX_DIM, N_IDX_HEADS)
D_IN = A_Q + 2 * A_KV + 3 * B_QKV + C_Q + C_KV_LATENT + C_QIDX + IDX_DIM + N_IDX_HEADS

kernel_name = "hymba_style_swa_moba_dsa_macaron"


def _rmsnorm(x, g):
    x32 = x.astype(jnp.float32)
    y = x32 * lax.rsqrt(jnp.mean(x32 * x32, axis=-1, keepdims=True) + RMS_EPS)
    return (y * g.astype(jnp.float32)).astype(x.dtype)


def _swiglu(x, w_gate, w_up, w_down):
    return (jax.nn.silu(x @ w_gate) * (x @ w_up)) @ w_down


def _t5_bucket(dist):
    n = jnp.maximum(dist, 0)
    max_exact = N_BUCKETS // 2
    nf = jnp.maximum(n, 1).astype(jnp.float32)
    large = max_exact + (jnp.log(nf / max_exact) / math.log(MAX_DISTANCE / max_exact)
                         * (N_BUCKETS - max_exact)).astype(jnp.int32)
    large = jnp.minimum(large, N_BUCKETS - 1)
    return jnp.where(n < max_exact, n, large)


def _split_cols(p):
    cuts = []
    acc = 0
    for sz in COL_SIZES[:-1]:
        acc += sz
        cuts.append(acc)
    return jnp.split(p, cuts, axis=-1)


def _sliding_window_attn(q, k, v, sinks, bias_tab):
    B, T = q.shape[0], q.shape[1]
    nq = T // Q_BLOCK
    G = N_HEADS_A // N_KV_A
    pad = ((0, 0), (WINDOW, 0), (0, 0), (0, 0))
    kp = jnp.pad(k, pad).reshape(B, nq + 1, Q_BLOCK, N_KV_A, HEAD_DIM)
    vp = jnp.pad(v, pad).reshape(B, nq + 1, Q_BLOCK, N_KV_A, HEAD_DIM)
    kb = jnp.concatenate([kp[:, :-1], kp[:, 1:]], axis=2)
    vb = jnp.concatenate([vp[:, :-1], vp[:, 1:]], axis=2)
    qb = q.reshape(B, nq, Q_BLOCK, N_KV_A, G, HEAD_DIM)
    s = jnp.einsum('bnqkgd,bnskd->bnkgqs', qb, kb).astype(jnp.float32) * (HEAD_DIM ** -0.5)
    qi = jnp.arange(Q_BLOCK)[:, None]
    si = jnp.arange(2 * Q_BLOCK)[None, :]
    dist = WINDOW + qi - si
    bias = bias_tab[:, _t5_bucket(dist)].astype(jnp.float32)
    bias = bias.reshape(N_KV_A, G, Q_BLOCK, 2 * Q_BLOCK)
    key_pos = jnp.arange(nq)[:, None] * Q_BLOCK - WINDOW + si
    valid = ((dist >= 0) & (dist < WINDOW))[None] & (key_pos >= 0)[:, None, :]
    s = jnp.where(valid[None, :, None, None], s + bias, -jnp.inf)
    sink = sinks.astype(jnp.float32).reshape(N_KV_A, G)[None, None, :, :, None, None]
    m = jnp.maximum(jnp.max(s, axis=-1, keepdims=True), sink)
    p = jnp.exp(s - m)
    denom = jnp.sum(p, axis=-1, keepdims=True) + jnp.exp(sink - m)
    o = jnp.einsum('bnkgqs,bnskd->bnqkgd', (p / denom).astype(v.dtype), vb)
    return o.reshape(B, T, N_HEADS_A * HEAD_DIM)


def _moba_attn(q, k, v, bias_tab):
    B, T = q.shape[0], q.shape[1]
    nb = -(-T // MOBA_BLOCK)
    Tp = nb * MOBA_BLOCK
    pad = ((0, 0), (0, Tp - T), (0, 0), (0, 0))
    kbh = jnp.pad(k, pad).reshape(B, nb, MOBA_BLOCK, N_HEADS_B, HEAD_DIM).transpose(0, 3, 1, 2, 4)
    vbh = jnp.pad(v, pad).reshape(B, nb, MOBA_BLOCK, N_HEADS_B, HEAD_DIM).transpose(0, 3, 1, 2, 4)
    n_sel = min(MOBA_TOPK, nb - 1)
    scale = HEAD_DIM ** -0.5
    h_idx = jnp.arange(N_HEADS_B)[None, :, None, None]
    b_idx = jnp.arange(B)[:, None, None, None]
    if n_sel > 0:
        k_mean = jnp.mean(kbh.astype(jnp.float32), axis=3)
        gate = jnp.einsum('bthd,bhnd->bhtn', q.astype(jnp.float32), k_mean)
        own_all = jnp.arange(T) // MOBA_BLOCK
        past = jnp.arange(nb)[None, :] < own_all[:, None]
        gate = jnp.where(past[None, None], gate, -jnp.inf)
        _, sel_idx = lax.top_k(gate, n_sel)

    def chunk(i):
        t0 = i * Q_BLOCK
        tq = t0 + jnp.arange(Q_BLOCK)
        qc = lax.dynamic_slice_in_dim(q, t0, Q_BLOCK, axis=1).transpose(0, 2, 1, 3)
        ob = t0 // MOBA_BLOCK
        k_own = lax.dynamic_index_in_dim(kbh, ob, axis=2, keepdims=False)
        v_own = lax.dynamic_index_in_dim(vbh, ob, axis=2, keepdims=False)
        d_own = tq[:, None] - (ob * MOBA_BLOCK + jnp.arange(MOBA_BLOCK))[None, :]
        s_own = (jnp.einsum('bhqd,bhsd->bhqs', qc, k_own).astype(jnp.float32) * scale
                 + bias_tab[:, _t5_bucket(d_own)].astype(jnp.float32)[None])
        s_own = jnp.where((d_own >= 0)[None, None], s_own, -jnp.inf)
        if n_sel == 0:
            p_own = jax.nn.softmax(s_own, axis=-1)
            o = jnp.einsum('bhqs,bhsd->bhqd', p_own.astype(v.dtype), v_own)
            return o.transpose(0, 2, 1, 3)
        idx_c = lax.dynamic_slice_in_dim(sel_idx, t0, Q_BLOCK, axis=2)
        k_sel = kbh[b_idx, h_idx, idx_c]
        v_sel = vbh[b_idx, h_idx, idx_c]
        sel_pos = idx_c[..., None] * MOBA_BLOCK + jnp.arange(MOBA_BLOCK)
        d_sel = tq[None, None, :, None, None] - sel_pos
        b_sel = bias_tab[h_idx[..., None], _t5_bucket(d_sel)].astype(jnp.float32)
        s_sel = jnp.einsum('bhqd,bhqjsd->bhqjs', qc, k_sel).astype(jnp.float32) * scale + b_sel
        ok = (idx_c < (tq // MOBA_BLOCK)[None, None, :, None])[..., None]
        s_sel = jnp.where(ok, s_sel, -jnp.inf).reshape(B, N_HEADS_B, Q_BLOCK, n_sel * MOBA_BLOCK)
        p = jax.nn.softmax(jnp.concatenate([s_sel, s_own], axis=-1), axis=-1).astype(v.dtype)
        p_sel = p[..., :n_sel * MOBA_BLOCK].reshape(B, N_HEADS_B, Q_BLOCK, n_sel, MOBA_BLOCK)
        p_own = p[..., n_sel * MOBA_BLOCK:]
        o = (jnp.einsum('bhqjs,bhqjsd->bhqd', p_sel, v_sel)
             + jnp.einsum('bhqs,bhsd->bhqd', p_own, v_own))
        return o.transpose(0, 2, 1, 3)

    out = lax.map(chunk, jnp.arange(T // Q_BLOCK))
    return out.transpose(1, 0, 2, 3, 4).reshape(B, T, N_HEADS_B * HEAD_DIM)


def _dsa_attn(q, k, v, q_idx, k_idx, w_idx, bias_tab):
    B, T = q.shape[0], q.shape[1]
    n_keep = min(DSA_TOPK, T // 4)
    key_pos = jnp.arange(T)
    b_idx = jnp.arange(B)[:, None, None]
    scale = HEAD_DIM ** -0.5

    def chunk(i):
        t0 = i * Q_BLOCK
        tq = t0 + jnp.arange(Q_BLOCK)
        qi = lax.dynamic_slice_in_dim(q_idx, t0, Q_BLOCK, axis=1)
        wi = lax.dynamic_slice_in_dim(w_idx, t0, Q_BLOCK, axis=1).astype(jnp.float32)
        dots = jnp.einsum('bqhd,bsd->bqhs', qi, k_idx).astype(jnp.float32) * (IDX_DIM ** -0.5)
        score = jnp.einsum('bqhs,bqh->bqs', jax.nn.relu(dots), wi)
        score = jnp.where((key_pos[None, :] <= tq[:, None])[None], score, -jnp.inf)
        _, idx = lax.top_k(score, n_keep)
        k_sel = k[b_idx, idx]
        v_sel = v[b_idx, idx]
        qc = lax.dynamic_slice_in_dim(q, t0, Q_BLOCK, axis=1)
        d = tq[None, :, None] - idx
        bias = bias_tab[:, _t5_bucket(d)].astype(jnp.float32).transpose(1, 0, 2, 3)
        s = jnp.einsum('bqhd,bqkd->bhqk', qc, k_sel).astype(jnp.float32) * scale + bias
        s = jnp.where((d >= 0)[:, None], s, -jnp.inf)
        p = jax.nn.softmax(s, axis=-1).astype(v.dtype)
        return jnp.einsum('bhqk,bqkd->bqhd', p, v_sel)

    out = lax.map(chunk, jnp.arange(T // Q_BLOCK))
    return out.transpose(1, 0, 2, 3, 4).reshape(B, T, N_HEADS_C * HEAD_DIM)


def setup_inputs(seed: int = 0) -> dict:
    key = jax.random.key(seed)
    ks = jax.random.split(key, 18)

    def nrm(k, shape, fan_in):
        return jax.random.normal(k, shape, jnp.float32) * (fan_in ** -0.5)

    def gain(k, shape):
        return 1.0 + 0.05 * jax.random.normal(k, shape, jnp.float32)

    return {
        "x": jax.random.normal(ks[0], (BATCH, SEQ, D_MODEL), jnp.float32),
        "rel_bias_table": 0.5 * jax.random.normal(ks[1], (N_BUCKETS, N_HEADS), jnp.float32),
        "ffn1_norm": gain(ks[2], (DEPTH, D_MODEL)),
        "ffn1_w_gate": nrm(ks[3], (DEPTH, D_MODEL, D_FF), D_MODEL),
        "ffn1_w_up": nrm(ks[4], (DEPTH, D_MODEL, D_FF), D_MODEL),
        "ffn1_w_down": nrm(ks[5], (DEPTH, D_FF, D_MODEL), D_FF),
        "mix_norm": gain(ks[6], (DEPTH, D_MODEL)),
        "w_in": nrm(ks[7], (DEPTH, D_MODEL, D_IN), D_MODEL),
        "attn_sinks": 0.5 * jax.random.normal(ks[8], (DEPTH, N_HEADS_A), jnp.float32),
        "kv_norm_c": gain(ks[9], (DEPTH, C_KV_LATENT)),
        "w_kv_up_c": nrm(ks[10], (DEPTH, C_KV_LATENT, 2 * HEAD_DIM), C_KV_LATENT),
        "w_out": nrm(ks[11], (DEPTH, D_MIX, D_MODEL), D_MIX),
        "ffn2_norm": gain(ks[12], (DEPTH, D_MODEL)),
        "ffn2_w_gate": nrm(ks[13], (DEPTH, D_MODEL, D_FF), D_MODEL),
        "ffn2_w_up": nrm(ks[14], (DEPTH, D_MODEL, D_FF), D_MODEL),
        "ffn2_w_down": nrm(ks[15], (DEPTH, D_FF, D_MODEL), D_FF),
        "final_norm": gain(ks[16], (D_MODEL,)),
    }


def reference(x, rel_bias_table, ffn1_norm, ffn1_w_gate, ffn1_w_up, ffn1_w_down, mix_norm, w_in,
              attn_sinks, kv_norm_c, w_kv_up_c, w_out, ffn2_norm, ffn2_w_gate, ffn2_w_up,
              ffn2_w_down, final_norm):
    B, T = x.shape[0], x.shape[1]
    tab = rel_bias_table.T
    tab_a = tab[:N_HEADS_A]
    tab_b = tab[N_HEADS_A:N_HEADS_A + N_HEADS_B]
    tab_c = tab[N_HEADS_A + N_HEADS_B:]
    for l in range(DEPTH):
        x = x + 0.5 * _swiglu(_rmsnorm(x, ffn1_norm[l]), ffn1_w_gate[l], ffn1_w_up[l], ffn1_w_down[l])
        h = _rmsnorm(x, mix_norm[l])
        (qa, ka, va, qb, kb, vb, qc, ckv, qidx, kidx, widx) = _split_cols(h @ w_in[l])
        out_a = _sliding_window_attn(qa.reshape(B, T, N_HEADS_A, HEAD_DIM),
                                     ka.reshape(B, T, N_KV_A, HEAD_DIM),
                                     va.reshape(B, T, N_KV_A, HEAD_DIM),
                                     attn_sinks[l], tab_a)
        out_b = _moba_attn(qb.reshape(B, T, N_HEADS_B, HEAD_DIM),
                           kb.reshape(B, T, N_HEADS_B, HEAD_DIM),
                           vb.reshape(B, T, N_HEADS_B, HEAD_DIM), tab_b)
        kv_c = _rmsnorm(ckv, kv_norm_c[l]) @ w_kv_up_c[l]
        out_c = _dsa_attn(qc.reshape(B, T, N_HEADS_C, HEAD_DIM),
                          kv_c[..., :HEAD_DIM], kv_c[..., HEAD_DIM:],
                          qidx.reshape(B, T, N_IDX_HEADS, IDX_DIM), kidx,
                          widx * (N_IDX_HEADS ** -0.5), tab_c)
        x = x + jnp.concatenate([out_a, out_b, out_c], axis=-1) @ w_out[l]
        x = x + 0.5 * _swiglu(_rmsnorm(x, ffn2_norm[l]), ffn2_w_gate[l], ffn2_w_up[l], ffn2_w_down[l])
    return _rmsnorm(x, final_norm)
```

```cpp
#include <hip/hip_runtime.h>
#include <cstdio>
#include <cstdint>
#include <cmath>
namespace pg8 {
#define PG8_LAS __attribute__((address_space(3)))
typedef unsigned short bf16_t;
typedef short bf16x8 __attribute__((ext_vector_type(8)));
typedef float f32x4 __attribute__((ext_vector_type(4)));
typedef unsigned u32x4 __attribute__((ext_vector_type(4)));
constexpr int BM = 256, BK = 64, HALF = 128, HTB = HALF * BK * 2  , STAGE_BYTES = 8 * HTB, NXCD = 8, WGM = 8;

__host__ __device__ __forceinline__ int lds_byte(int r, int c) { const int st = (r >> 4) * 2 + (c >> 5), rr = r & 15, cc = c & 31, ob = rr * 64 + cc * 2; return st * 1024 + (ob ^ (((ob >> 9) & 1) << 5)); }
__host__ __device__ __forceinline__ void stage_rc(int b, int& R, int& C) { const int st = b / 1024, sb = b % 1024, swz = sb ^ (((sb >> 9) & 1) << 5); R = (st >> 1) * 16 + swz / 64; C = (st & 1) * 32 + (swz % 64) / 2; }
__host__ __device__ __forceinline__ int perm32(int rho) { const int n = rho >> 4, i = rho & 15; return 8 * (i >> 2) + 4 * n + (i & 3); }

struct Unit { int pm, pn; };
struct Gemm { const bf16_t* A; const bf16_t* Bt; int M, N, K; };

struct StaticOrder {
    int nM, nN, nwg, G, c;
    __host__ __device__ void init(int M, int N, int G_, int c_) { nM = M / BM; nN = N / BM; nwg = nM * nN; G = G_; c = c_; }
    __host__ __device__ bool next(int i, Unit& u) const {
        const long L = (long)i * G + c; if (L >= nwg) return false;
        int wgid = (int)L; { const int q = nwg / NXCD, r = nwg % NXCD, xcd = wgid % NXCD, off = wgid / NXCD; wgid = (xcd < r ? xcd * (q + 1) : r * (q + 1) + (xcd - r) * q) + off; }
        const int nig = WGM * nN, gid = wgid / nig, fm = gid * WGM, gsz = (nM - fm) < WGM ? (nM - fm) : WGM;
        u.pm = fm + ((wgid % nig) % gsz); u.pn = (wgid % nig) / gsz; return true;
    }
    __device__ __forceinline__ void a_ready(const Unit&) const {}
    __device__ __forceinline__ void done(const Unit&) const {}
};

__device__ __forceinline__ unsigned cvt_pk_bf16(float lo, float hi) { unsigned r; asm volatile("v_cvt_pk_bf16_f32 %0, %1, %2" : "=v"(r) : "v"(lo), "v"(hi)); return r; }
typedef float f32x2 __attribute__((ext_vector_type(2)));
__device__ __forceinline__ float row_rstd(const float* ss, int row) {
    const f32x4* p = (const f32x4*)(ss + (size_t)row * 16);
    const f32x4 a = p[0], b = p[1], c = p[2], d = p[3];
    const float s = (((a[0] + a[1]) + (a[2] + a[3])) + ((b[0] + b[1]) + (b[2] + b[3]))) + (((c[0] + c[1]) + (c[2] + c[3])) + ((d[0] + d[1]) + (d[2] + d[3])));
    return 1.0f / sqrtf(s * (1.0f / 1024.0f) + 1e-6f);
}
__device__ __forceinline__ void rows_rstd(const float* ss, int row0, int fq, float (&rs)[8]) {
    f32x4 v[8];
#pragma unroll
    for (int i = 0; i < 8; ++i) v[i] = *(const f32x4*)(ss + (size_t)(row0 + (i >> 2) * HALF + (i & 3) * 16) * 16 + 4 * fq);
#pragma unroll
    for (int i = 0; i < 8; ++i) { float s = (v[i][0] + v[i][1]) + (v[i][2] + v[i][3]); s += __shfl_xor(s, 16); s += __shfl_xor(s, 32); rs[i] = 1.0f / sqrtf(s * (1.0f / 1024.0f) + 1e-6f); }
}
__device__ __forceinline__ float silu_mul(float g, float u) {
    const float e = __builtin_amdgcn_exp2f(g * -1.4426950408889634f);
    return g * __builtin_amdgcn_rcpf(1.0f + e) * u;
}
struct EpiSwiGLU {
    static constexpr bool PERM = true, AFTER_DRAIN = false;
    bf16_t* O; int ldc; const float* ss;
    __device__ __forceinline__ void operator()(const f32x4 (&acc)[2][2][4][2], const Unit& u, int wr, int wc, int fr, int fq) const {
        const int row0 = u.pm * BM + wr * 64 + fr, col0 = u.pn * HALF + wc * 32 + 8 * fq;
        float rs[8]; rows_rstd(ss, row0, fq, rs);
#pragma unroll
        for (int ai = 0; ai < 2; ++ai)
#pragma unroll
            for (int m = 0; m < 4; ++m) { const int row = row0 + ai * HALF + m * 16; const float r = rs[ai * 4 + m];
                const f32x4 g0 = acc[ai][0][m][0] * r, g1 = acc[ai][0][m][1] * r, u0 = acc[ai][1][m][0] * r, u1 = acc[ai][1][m][1] * r;
                u32x4 w; w.x = cvt_pk_bf16(silu_mul(g0[0], u0[0]), silu_mul(g0[1], u0[1])); w.y = cvt_pk_bf16(silu_mul(g0[2], u0[2]), silu_mul(g0[3], u0[3]));
                w.z = cvt_pk_bf16(silu_mul(g1[0], u1[0]), silu_mul(g1[1], u1[1])); w.w = cvt_pk_bf16(silu_mul(g1[2], u1[2]), silu_mul(g1[3], u1[3]));
                *(u32x4*)(O + (size_t)row * ldc + col0) = w; }
    }
};
struct EpiResid {
    static constexpr bool PERM = false, AFTER_DRAIN = false;
    const float* xin; float* xout; bf16_t* xb; float* ss; float alpha;
    __device__ __forceinline__ void operator()(const f32x4 (&acc)[2][2][4][2], const Unit& u, int wr, int wc, int fr, int fq) const {
        typedef unsigned u32x2v __attribute__((ext_vector_type(2)));
        const int row0 = u.pm * BM + wr * 64 + fr, col0 = u.pn * BM + wc * 32 + 4 * fq;
#pragma unroll
        for (int ai = 0; ai < 2; ++ai)
#pragma unroll
            for (int m = 0; m < 4; ++m) { const int row = row0 + ai * HALF + m * 16; const size_t off = (size_t)row * 1024 + col0; float sq = 0.f;
#pragma unroll
                for (int bj = 0; bj < 2; ++bj)
#pragma unroll
                    for (int n = 0; n < 2; ++n) { const size_t o2 = off + bj * HALF + n * 16; const f32x4 x = *(const f32x4*)(xin + o2); const f32x4 o = x + acc[ai][bj][m][n] * alpha;
                        *(f32x4*)(xout + o2) = o; u32x2v w; w.x = cvt_pk_bf16(o[0], o[1]); w.y = cvt_pk_bf16(o[2], o[3]); *(u32x2v*)(xb + o2) = w;
                        sq += (o[0] * o[0] + o[1] * o[1]) + (o[2] * o[2] + o[3] * o[3]); }
                sq += __shfl_xor(sq, 16); sq += __shfl_xor(sq, 32);
                if (fq == 0) ss[(size_t)row * 16 + u.pn * 4 + wc] = sq; }
    }
};
struct EpiProj {
    static constexpr bool PERM = true, AFTER_DRAIN = false;
    bf16_t* P; float* PF; const float* ss; float qscale;
    __device__ __forceinline__ void operator()(const f32x4 (&acc)[2][2][4][2], const Unit& u, int wr, int wc, int fr, int fq) const {
        const int row0 = u.pm * BM + wr * 64 + fr, col0 = u.pn * BM + wc * 32 + 8 * fq;
        const float sc = (u.pn <= 1 || u.pn == 3 || u.pn == 6) ? qscale : 1.0f;
        float rs[8]; rows_rstd(ss, row0, fq, rs);
#pragma unroll
        for (int ai = 0; ai < 2; ++ai)
#pragma unroll
            for (int m = 0; m < 4; ++m) { const int row = row0 + ai * HALF + m * 16; const float r = rs[ai * 4 + m] * sc;
#pragma unroll
                for (int bj = 0; bj < 2; ++bj) { const f32x4 v0 = acc[ai][bj][m][0] * r, v1 = acc[ai][bj][m][1] * r;
                    u32x4 w; w.x = cvt_pk_bf16(v0[0], v0[1]); w.y = cvt_pk_bf16(v0[2], v0[3]); w.z = cvt_pk_bf16(v1[0], v1[1]); w.w = cvt_pk_bf16(v1[2], v1[3]);
                    *(u32x4*)(P + (size_t)row * 2304 + col0 + bj * HALF) = w;
                    if (u.pn >= 7) { float* pf = PF + (size_t)row * 512 + (col0 - 1792) + bj * HALF; *(f32x4*)pf = v0; *(f32x4*)(pf + 4) = v1; } } }
    }
};
template <class Epi, class Sched, bool ALIGN_EPI = false, bool SP2 = false>
__device__ __forceinline__ void gemm_phase(PG8_LAS unsigned char* lds, const Gemm g, const Sched& S, const Epi& E) {
    int tid_ = threadIdx.x; asm volatile("" : "+v"(tid_));
    const int tid = tid_, wid = __builtin_amdgcn_readfirstlane(tid >> 6), lane = tid & 63, wr = wid >> 2, wc = wid & 3, fr = lane & 15, fq = lane >> 4;
    const int K = g.K, nt = K / BK;
    unsigned voffA[2], voffB[2];
#pragma unroll
    for (int i = 0; i < 2; ++i) { int R, C; stage_rc(tid * 16 + i * 8192, R, C); const int Rb = Epi::PERM ? ((R & ~31) + perm32(R & 31)) : R;
        voffA[i] = (unsigned)(R * K + C) * 2u; voffB[i] = (unsigned)(Rb * K + C) * 2u; }
    const size_t kstep = (size_t)(BK * 2);
    const size_t hstep = (size_t)HALF * K * 2;
    const size_t tstep = 2 * hstep;
    const unsigned ldsw = (unsigned)wid * 1024u;
    const int aoff = lds_byte(wr * 64 + fr, fq * 8), boff = lds_byte(wc * 32 + fr, fq * 8);
#define PG8_SA(b, h) (((b) * 2 + (h)) * HTB)
#define PG8_SB(b, h) ((4 + (b) * 2 + (h)) * HTB)
#define PG8_STAGE(bufoff, gbase, voff) do { _Pragma("unroll") for (int _i = 0; _i < 2; ++_i) \
        __builtin_amdgcn_global_load_lds((const unsigned*)((const char*)(gbase) + (voff)[_i]), (PG8_LAS unsigned*)(lds + (bufoff) + ldsw + _i * 8192), 16, 0, 0); } while (0)
#define PG8_LDA(dst, b, h) do { _Pragma("unroll") for (int m = 0; m < 4; ++m) _Pragma("unroll") for (int k = 0; k < 2; ++k) dst[m][k] = *(const PG8_LAS bf16x8*)(lds + PG8_SA(b, h) + aoff + m * 2048 + k * 1024); } while (0)
#define PG8_LDB(dst, b, h) do { _Pragma("unroll") for (int n = 0; n < 2; ++n) _Pragma("unroll") for (int k = 0; k < 2; ++k) dst[n][k] = *(const PG8_LAS bf16x8*)(lds + PG8_SB(b, h) + boff + n * 2048 + k * 1024); } while (0)
#define PG8_MMA(ai, bj, At, Bt) do { __builtin_amdgcn_s_setprio(1); _Pragma("unroll") for (int m = 0; m < 4; ++m) _Pragma("unroll") for (int n = 0; n < 2; ++n) _Pragma("unroll") for (int k = 0; k < 2; ++k) \
        acc[ai][bj][m][n] = __builtin_amdgcn_mfma_f32_16x16x32_bf16(Bt[n][k], At[m][k], acc[ai][bj][m][n], 0, 0, 0); __builtin_amdgcn_s_setprio(0); } while (0)
#define PG8_WAIT_V(n) asm volatile("s_waitcnt vmcnt(" #n ")" ::: "memory")
#define PG8_WAIT_L(n) asm volatile("s_waitcnt lgkmcnt(" #n ")" ::: "memory")
#define PG8_BAR __builtin_amdgcn_s_barrier()
#define PG8_SCHED __builtin_amdgcn_sched_barrier(0)
    Unit cur, nxt; int ui = 0;
    if (!S.next(0, cur)) return;
    f32x4 acc[2][2][4][2];
#pragma unroll
    for (int a = 0; a < 2; ++a)
#pragma unroll
        for (int b = 0; b < 2; ++b)
#pragma unroll
            for (int m = 0; m < 4; ++m)
#pragma unroll
                for (int n = 0; n < 2; ++n) acc[a][b][m][n] = (f32x4){0.f, 0.f, 0.f, 0.f};
    bf16x8 At[4][2], B0[2][2], B1[2][2];
    const char* cA = (const char*)g.A + (size_t)cur.pm * tstep; const char* cB = (const char*)g.Bt + (size_t)cur.pn * tstep;
    S.a_ready(cur);
    if constexpr (SP2) {
        PG8_STAGE(PG8_SB(0, 0), cB, voffB); PG8_STAGE(PG8_SB(0, 1), cB + hstep, voffB); PG8_STAGE(PG8_SA(0, 0), cA, voffA); PG8_STAGE(PG8_SA(0, 1), cA + hstep, voffA);
        if (wr == 1) PG8_BAR;
        PG8_WAIT_V(2); PG8_BAR;
        PG8_STAGE(PG8_SB(1, 0), cB + kstep, voffB); PG8_STAGE(PG8_SA(1, 0), cA + kstep, voffA); PG8_STAGE(PG8_SB(1, 1), cB + hstep + kstep, voffB);
        PG8_WAIT_V(6); PG8_BAR;
    } else {
        PG8_STAGE(PG8_SB(0, 0), cB, voffB); PG8_STAGE(PG8_SA(0, 0), cA, voffA); PG8_STAGE(PG8_SB(0, 1), cB + hstep, voffB); PG8_STAGE(PG8_SA(0, 1), cA + hstep, voffA);
        if (wr == 1) PG8_BAR;
        PG8_WAIT_V(4); PG8_BAR;
        PG8_STAGE(PG8_SB(1, 0), cB + kstep, voffB); PG8_STAGE(PG8_SA(1, 0), cA + kstep, voffA); PG8_STAGE(PG8_SB(1, 1), cB + hstep + kstep, voffB);
        PG8_WAIT_V(6); PG8_BAR;
    }
    for (;;) {
        const bool has_next = S.next(ui + 1, nxt);
        const char* nA = has_next ? (const char*)g.A + (size_t)nxt.pm * tstep : cA; const char* nB = has_next ? (const char*)g.Bt + (size_t)nxt.pn * tstep : cB;
        for (int t = 0; t < nt; t += 2) {
            const bool last = (t == nt - 2);
            const char* a1 = cA + (size_t)(t + 1) * kstep;
            const char* a2 = last ? nA : cA + (size_t)(t + 2) * kstep; const char* b2 = last ? nB : cB + (size_t)(t + 2) * kstep;
            const char* a3 = a2 + kstep; const char* b3 = b2 + kstep;
            if (last && has_next) S.a_ready(nxt);
            if constexpr (SP2) {
            PG8_LDB(B0, 0, 0); PG8_LDB(B1, 0, 1); PG8_SCHED; PG8_LDA(At, 0, 0); PG8_STAGE(PG8_SA(1, 1), a1 + hstep, voffA);
            PG8_WAIT_V(8); PG8_WAIT_L(0); PG8_BAR; PG8_MMA(0, 0, At, B0); PG8_MMA(0, 1, At, B1); PG8_BAR; PG8_SCHED;
            PG8_LDA(At, 0, 1); PG8_STAGE(PG8_SB(0, 0), b2, voffB); PG8_STAGE(PG8_SB(0, 1), b2 + hstep, voffB); PG8_STAGE(PG8_SA(0, 0), a2, voffA);
            PG8_WAIT_V(8); PG8_WAIT_L(0); PG8_BAR; PG8_MMA(1, 0, At, B0); PG8_MMA(1, 1, At, B1); PG8_BAR; PG8_SCHED;
            PG8_LDB(B0, 1, 0); PG8_LDB(B1, 1, 1); PG8_SCHED; PG8_LDA(At, 1, 0); PG8_STAGE(PG8_SA(0, 1), a2 + hstep, voffA);
            PG8_WAIT_V(8); PG8_WAIT_L(0); PG8_BAR; PG8_MMA(0, 0, At, B0); PG8_MMA(0, 1, At, B1); PG8_BAR; PG8_SCHED;
            PG8_LDA(At, 1, 1); PG8_STAGE(PG8_SB(1, 0), b3, voffB); PG8_STAGE(PG8_SB(1, 1), b3 + hstep, voffB); PG8_STAGE(PG8_SA(1, 0), a3, voffA);
            PG8_WAIT_V(8); PG8_WAIT_L(0); PG8_BAR; PG8_MMA(1, 0, At, B0); PG8_MMA(1, 1, At, B1); PG8_BAR; PG8_SCHED;
            } else {
            PG8_LDB(B0, 0, 0); PG8_SCHED; PG8_LDA(At, 0, 0); PG8_STAGE(PG8_SA(1, 1), a1 + hstep, voffA);
            PG8_WAIT_L(8); PG8_BAR; PG8_WAIT_L(0); PG8_MMA(0, 0, At, B0); PG8_BAR; PG8_SCHED;
            PG8_LDB(B1, 0, 1); PG8_STAGE(PG8_SB(0, 0), b2, voffB);
            PG8_BAR; PG8_WAIT_L(0); PG8_MMA(0, 1, At, B1); PG8_BAR;
            PG8_LDA(At, 0, 1); PG8_STAGE(PG8_SA(0, 0), a2, voffA);
            PG8_BAR; PG8_WAIT_L(0); PG8_MMA(1, 0, At, B0); PG8_BAR; PG8_SCHED;
            PG8_STAGE(PG8_SB(0, 1), b2 + hstep, voffB);
            PG8_WAIT_V(6); PG8_BAR; PG8_MMA(1, 1, At, B1); PG8_BAR;
            PG8_LDB(B0, 1, 0); PG8_SCHED; PG8_LDA(At, 1, 0); PG8_STAGE(PG8_SA(0, 1), a2 + hstep, voffA);
            PG8_WAIT_L(8); PG8_BAR; PG8_WAIT_L(0); PG8_MMA(0, 0, At, B0); PG8_BAR; PG8_SCHED;
            PG8_LDB(B1, 1, 1); PG8_STAGE(PG8_SB(1, 0), b3, voffB);
            PG8_BAR; PG8_WAIT_L(0); PG8_MMA(0, 1, At, B1); PG8_BAR;
            PG8_LDA(At, 1, 1); PG8_STAGE(PG8_SA(1, 0), a3, voffA);
            PG8_BAR; PG8_WAIT_L(0); PG8_MMA(1, 0, At, B0); PG8_BAR; PG8_SCHED;
            PG8_STAGE(PG8_SB(1, 1), b3 + hstep, voffB);
            PG8_WAIT_V(6); PG8_BAR; PG8_MMA(1, 1, At, B1); PG8_BAR;
            }
        }
        if constexpr (ALIGN_EPI) { if (wr == 0) PG8_BAR; }
        if constexpr (!Epi::AFTER_DRAIN) { E(acc, cur, wr, wc, fr, fq); S.done(cur); }
        if (!has_next) break;
#pragma unroll
        for (int a = 0; a < 2; ++a)
#pragma unroll
            for (int b = 0; b < 2; ++b)
#pragma unroll
                for (int m = 0; m < 4; ++m)
#pragma unroll
                    for (int n = 0; n < 2; ++n) acc[a][b][m][n] = (f32x4){0.f, 0.f, 0.f, 0.f};
        cur = nxt; cA = nA; cB = nB; ++ui;
        if constexpr (ALIGN_EPI) { if (wr == 1) PG8_BAR; }
    }
    PG8_WAIT_V(0);
    if constexpr (!ALIGN_EPI) { if (wr == 0) PG8_BAR; }
    PG8_BAR;
    if constexpr (Epi::AFTER_DRAIN) { E.fused(acc, cur, wr, wc, fr, fq, lds, wid, lane); S.done(cur); }
#undef PG8_SA
#undef PG8_SB
#undef PG8_STAGE
#undef PG8_LDA
#undef PG8_LDB
#undef PG8_MMA
#undef PG8_WAIT_V
#undef PG8_WAIT_L
#undef PG8_BAR
#undef PG8_SCHED
}
}
#define GAS __attribute__((address_space(1)))
#define LAS __attribute__((address_space(3)))
typedef unsigned short bf16;
typedef unsigned v4u __attribute__((ext_vector_type(4)));
typedef float f32x4 __attribute__((ext_vector_type(4)));
typedef short bf16x8 __attribute__((ext_vector_type(8)));
typedef GAS unsigned gu32;
typedef GAS unsigned long long gu64;
#define RLX_AGENT __ATOMIC_RELAXED, __HIP_MEMORY_SCOPE_AGENT
#define LDS_WAIT() asm volatile("s_waitcnt lgkmcnt(0)" ::: "memory")
#define VM_WAIT() asm volatile("s_waitcnt vmcnt(0)" ::: "memory")
__device__ __forceinline__ unsigned long long rt() { return __builtin_amdgcn_s_memrealtime(); }
__device__ __forceinline__ unsigned f2bf(float f) { unsigned u = __builtin_bit_cast(unsigned, f); return (u + 0x7fffu + ((u >> 16) & 1u)) >> 16; }
__device__ __forceinline__ unsigned pk2(float lo, float hi) { return f2bf(lo) | (f2bf(hi) << 16); }

#define XB_TMO      128
#define XB_XCNT(j)  (256  + 64 * (j))
#define XB_XSUB(j)  (1280 + 64 * (j))
#define XB_XGEN(j)  (2304 + 64 * (j))
#define XB_TOP      3328
#define XB_TOPGEN   3392
#define XCD_BAR_WORDS 3456
#define XB_SPIN_CAP (1u << 18)

__device__ __forceinline__ unsigned xb_ld(unsigned* p)              { return __hip_atomic_load(p, __ATOMIC_RELAXED, __HIP_MEMORY_SCOPE_AGENT); }
__device__ __forceinline__ unsigned xb_add(unsigned* p, unsigned v) { return __hip_atomic_fetch_add(p, v, __ATOMIC_RELAXED, __HIP_MEMORY_SCOPE_AGENT); }
__device__ __forceinline__ unsigned xb_xcc_id() { return (unsigned)__builtin_amdgcn_s_getreg((3 << 11) | 20) & 0xFu; }
#define XB_SPIN(cond, bar) do { unsigned _sp = 0; while (cond) { __builtin_amdgcn_s_sleep(1); \
    if ((++_sp & 255u) == 0u) { if (xb_ld(&(bar)[XB_TMO])) break; if (_sp > XB_SPIN_CAP) { atomicAdd(&(bar)[XB_TMO], 1u); break; } } } } while (0)

struct XcdBarrier {
    unsigned* bar; unsigned x;
    volatile LAS unsigned* st;
};

__device__ __forceinline__ XcdBarrier xcd_barrier_post(unsigned* bar, volatile LAS unsigned* st) {
    XcdBarrier b; b.bar = bar; b.x = xb_xcc_id(); b.st = st;
    if (threadIdx.x == 0) (void)xb_add(&bar[XB_XCNT(b.x)], 1u);
    return b;
}
__device__ __forceinline__ void xcd_barrier_complete(unsigned* bar, unsigned x, unsigned& nloc, unsigned& nx) {
    const unsigned G = gridDim.x * gridDim.y * gridDim.z;
    unsigned sum, cnt, mine, sp = 0u;
    for (;;) {
        sum = 0u; cnt = 0u; mine = 0u;
#pragma unroll
        for (unsigned j = 0; j < 16; ++j) { const unsigned c = xb_ld(&bar[XB_XCNT(j)]); sum += c; cnt += (c > 0u) ? 1u : 0u; mine = (j == x) ? c : mine; }
        if (sum == G) break;
        __builtin_amdgcn_s_sleep(1);
        if ((++sp & 255u) == 0u) { if (xb_ld(&bar[XB_TMO])) break; if (sp > XB_SPIN_CAP) { atomicAdd(&bar[XB_TMO], 1u); break; } }
    }
    nloc = mine > 0u ? mine : 1u; nx = cnt > 0u ? cnt : 1u;
}

__device__ __forceinline__ void xcd_barrier(const XcdBarrier& b) {
    asm volatile("s_waitcnt vmcnt(0)" ::: "memory");
    __syncthreads();
    if (threadIdx.x == 0) {
        unsigned* bar = b.bar;
        __builtin_amdgcn_s_waitcnt(0);
        unsigned nloc = b.st[0], nx = b.st[1];
        if (nloc == 0u) { xcd_barrier_complete(bar, b.x, nloc, nx); b.st[0] = nloc; b.st[1] = nx; }
        const unsigned old = xb_add(&bar[XB_XSUB(b.x)], 1u);
        const unsigned gen = old / nloc;
        if (old + 1u == (gen + 1u) * nloc) {
            __builtin_amdgcn_fence(__ATOMIC_RELEASE, "agent");
            asm volatile("s_waitcnt vmcnt(0)" ::: "memory");
            const unsigned og = xb_add(&bar[XB_TOP], 1u);
            const unsigned tg = og / nx;
            if (og + 1u == (tg + 1u) * nx) xb_add(&bar[XB_TOPGEN], 1u);
            else XB_SPIN(xb_ld(&bar[XB_TOPGEN]) == tg, bar);
            __builtin_amdgcn_fence(__ATOMIC_ACQUIRE, "agent");
            xb_add(&bar[XB_XGEN(b.x)], 1u);
            asm volatile("s_waitcnt vmcnt(0)" ::: "memory");
        } else {
            XB_SPIN(xb_ld(&bar[XB_XGEN(b.x)]) == gen, bar);
            __builtin_amdgcn_fence(__ATOMIC_ACQUIRE, "agent");
            asm volatile("s_waitcnt vmcnt(0)" ::: "memory");
        }
    }
    __syncthreads();
}

constexpr int NWAVES = 8;
constexpr int BATCH = 4, T = 8192, D = 1024, M = BATCH * T, FF = 2816, NGU = 2 * FF, DIN = 2244, NP = 2304, DEPTH = 2;
constexpr int C_QA = 0, C_KA = 512, C_VA = 640, C_QB = 768, C_KB = 1024, C_VB = 1280, C_QC = 1536;
constexpr int PF_CKV = 0, PF_QIDX = 128, PF_KIDX = 384, PF_WIDX = 448;
constexpr float LOG2E = 1.4426950408889634f, QSCALE = 0.125f * LOG2E;
constexpr size_t MiB = 1u << 20;
constexpr size_t WS_CTL = 0, CTL_ZERO_BYTES = 1 * MiB;
constexpr size_t WS_W = 2 * MiB, W_LAYER = 40 * MiB;
constexpr size_t WO_GU1 = 0, WO_D1 = 11 * MiB, WO_IN = 16 * MiB + MiB / 2, WO_OUT = 21 * MiB, WO_GU2 = 23 * MiB, WO_D2 = 34 * MiB;
constexpr size_t WS_SS = 82 * MiB, WS_KMEAN = 84 * MiB, WS_KC = 85 * MiB, WS_VC = 89 * MiB;
constexpr size_t WS_XB = 96 * MiB, WS_ATT = 160 * MiB, WS_PF = 224 * MiB, WS_ACT = 288 * MiB, WS_END = 464 * MiB;
static_assert(WO_D2 + (size_t)D * FF * 2 <= W_LAYER && WS_W + 2 * W_LAYER <= WS_SS && WS_ACT + (size_t)M * FF * 2 <= WS_END, "ws map");
constexpr int CW_BAR = 4096;
constexpr int RING_OFF = 0, RING_BYTES = 131072;
constexpr int LDSCTL_OFF = RING_BYTES, MISC_OFF = LDSCTL_OFF + 320;
constexpr int LDS_BYTES = 147456;

struct Args {
    const float* x; const float* rbt; const float* n1; const float* g1; const float* u1; const float* d1; const float* nm; const float* win; const float* sinks; const float* kvn; const float* wkv;
    const float* wout; const float* n2; const float* g2; const float* u2; const float* d2; const float* nf; float* out; unsigned char* ws; int ph_lo, ph_hi;
};
struct Frame {
    LAS unsigned char* lds; volatile LAS unsigned* MISC; gu32* ctl;
    int G;
};
struct Ids { int tid, lane, wave; };
__device__ __forceinline__ Ids phase_ids() { int t = threadIdx.x; asm volatile("" : "+v"(t)); Ids I; I.tid = t; I.lane = t & 63; I.wave = __builtin_amdgcn_readfirstlane(t >> 6); return I; }
__device__ __forceinline__ float bf2f(unsigned h) { return __uint_as_float(h << 16); }
__device__ __forceinline__ float wave_sum(float v) {
#pragma unroll
    for (int o = 1; o < 64; o <<= 1) v += __shfl_xor(v, o);
    return v;
}
__device__ __forceinline__ float wave_max(float v) {
#pragma unroll
    for (int o = 1; o < 64; o <<= 1) v = fmaxf(v, __shfl_xor(v, o));
    return v;
}
__device__ __forceinline__ int t5_bucket(int n) {
    if (n < 16) return n;
    int b = 16;
    b += (n >= 19); b += (n >= 21); b += (n >= 24); b += (n >= 27); b += (n >= 31); b += (n >= 35); b += (n >= 40); b += (n >= 46);
    b += (n >= 52); b += (n >= 59); b += (n >= 67); b += (n >= 77); b += (n >= 87); b += (n >= 99); b += (n >= 113);
    return b;
}
__device__ __forceinline__ void tr_item(const float* W, int K, int N, bf16* WT, const float* gain, int mode, LAS float* scr, int item, int nblk, int lane) {
    const int kb = item / nblk, nb = item % nblk, k0 = 64 * kb, n0 = 32 * nb;
    const int nn = n0 + (lane & 31);
#pragma unroll 8
    for (int i = 0; i < 32; ++i) { const int kk = 2 * i + (lane >> 5); float w = (nn < N) ? W[(size_t)(k0 + kk) * N + nn] : 0.f; if (gain) w *= gain[k0 + kk]; scr[kk * 33 + (lane & 31)] = w; }
    LDS_WAIT(); asm volatile("" ::: "memory");
    const int c = lane & 7;
    const int orow0 = (mode == 0) ? n0 : (256 * (n0 >> 7) + (n0 & 127) + (mode == 2 ? 128 : 0));
#pragma unroll
    for (int j = 0; j < 4; ++j) { const int n = (lane >> 3) + 8 * j; const LAS float* s = scr + (8 * c) * 33 + n;
        v4u o; o.x = pk2(s[0 * 33], s[1 * 33]); o.y = pk2(s[2 * 33], s[3 * 33]); o.z = pk2(s[4 * 33], s[5 * 33]); o.w = pk2(s[6 * 33], s[7 * 33]);
        *(GAS v4u*)(WT + (size_t)(orow0 + n) * K + k0 + 8 * c) = o; }
    LDS_WAIT(); asm volatile("" ::: "memory");
}
__device__ __forceinline__ void p0_prologue(Frame& F, const Args& A) {
    const Ids I = phase_ids();
    LAS float* scr = (LAS float*)(F.lds + RING_OFF + I.wave * 16384);
    const int gw = blockIdx.x * NWAVES + I.wave, NGW = F.G * NWAVES;
    constexpr int I_GU = (D / 64) * (FF / 32), I_DN = (FF / 64) * (D / 32), I_IN = (D / 64) * (NP / 32), I_OUT = (D / 64) * (D / 32);
    constexpr int PER_LAYER = 3 * I_GU + 3 * I_DN + I_IN + I_OUT;
    for (int it = gw; it < DEPTH * PER_LAYER; it += NGW) {
        const int l = it / PER_LAYER; int r = it % PER_LAYER;
        unsigned char* wl = A.ws + WS_W + (size_t)l * W_LAYER;
        if (r < I_GU) { tr_item(A.g1 + (size_t)l * D * FF, D, FF, (bf16*)(wl + WO_GU1), A.n1 + l * D, 1, scr, r, FF / 32, I.lane); continue; } r -= I_GU;
        if (r < I_GU) { tr_item(A.u1 + (size_t)l * D * FF, D, FF, (bf16*)(wl + WO_GU1), A.n1 + l * D, 2, scr, r, FF / 32, I.lane); continue; } r -= I_GU;
        if (r < I_DN) { tr_item(A.d1 + (size_t)l * D * FF, FF, D, (bf16*)(wl + WO_D1), nullptr, 0, scr, r, D / 32, I.lane); continue; } r -= I_DN;
        if (r < I_IN) { tr_item(A.win + (size_t)l * D * DIN, D, DIN, (bf16*)(wl + WO_IN), A.nm + l * D, 0, scr, r, NP / 32, I.lane); continue; } r -= I_IN;
        if (r < I_OUT) { tr_item(A.wout + (size_t)l * D * D, D, D, (bf16*)(wl + WO_OUT), nullptr, 0, scr, r, D / 32, I.lane); continue; } r -= I_OUT;
        if (r < I_GU) { tr_item(A.g2 + (size_t)l * D * FF, D, FF, (bf16*)(wl + WO_GU2), A.n2 + l * D, 1, scr, r, FF / 32, I.lane); continue; } r -= I_GU;
        if (r < I_GU) { tr_item(A.u2 + (size_t)l * D * FF, D, FF, (bf16*)(wl + WO_GU2), A.n2 + l * D, 2, scr, r, FF / 32, I.lane); continue; } r -= I_GU;
        tr_item(A.d2 + (size_t)l * D * FF, FF, D, (bf16*)(wl + WO_D2), nullptr, 0, scr, r, D / 32, I.lane);
    }
    bf16* XB = (bf16*)(A.ws + WS_XB); float* SS = (float*)(A.ws + WS_SS);
    for (int m = gw; m < M; m += NGW) {
        const GAS f32x4* xr = (const GAS f32x4*)(A.x + (size_t)m * D) + I.lane;
        f32x4 v[4]; float s = 0.f;
#pragma unroll
        for (int j = 0; j < 4; ++j) { v[j] = xr[64 * j]; s += (v[j].x * v[j].x + v[j].y * v[j].y) + (v[j].z * v[j].z + v[j].w * v[j].w); }
        s = wave_sum(s);
        GAS unsigned long long* o8 = (GAS unsigned long long*)(XB + (size_t)m * D) + I.lane;
#pragma unroll
        for (int j = 0; j < 4; ++j) o8[64 * j] = (unsigned long long)pk2(v[j].x, v[j].y) | ((unsigned long long)pk2(v[j].z, v[j].w) << 32);
        if (I.lane < 16) SS[(size_t)m * 16 + I.lane] = (I.lane == 0) ? s : 0.f;
    }
}
__device__ __forceinline__ void prep_phase(Frame& F, const Args& A, int l) {
    const Ids I = phase_ids();
    const bf16* P = (const bf16*)(A.ws + WS_ACT); const float* PF = (const float*)(A.ws + WS_PF);
    float* KMEAN = (float*)(A.ws + WS_KMEAN); bf16* KC = (bf16*)(A.ws + WS_KC); bf16* VC = (bf16*)(A.ws + WS_VC);
    for (int it = blockIdx.x; it < BATCH * 32; it += F.G) {
        const int b = it >> 5, n = it & 31;
        if (I.tid < 256) { const int col = I.tid; const bf16* src = P + ((size_t)(b * T + n * 256)) * NP + C_KB + col; float s = 0.f;
#pragma unroll 16
            for (int i = 0; i < 256; ++i) s += bf2f(src[(size_t)i * NP]);
            KMEAN[((size_t)((b * 4 + (col >> 6)) * 32 + n)) * 64 + (col & 63)] = s * (1.0f / 256.0f); }
    }
    const float* Wkv = A.wkv + (size_t)l * 128 * 128; const float* kvg = A.kvn + l * 128;
    const int gw = blockIdx.x * NWAVES + I.wave, NGW = F.G * NWAVES;
    const float g0 = kvg[I.lane], g1 = kvg[64 + I.lane];
    for (int m = gw; m < M; m += NGW) {
        const float c0 = PF[(size_t)m * 512 + PF_CKV + I.lane], c1 = PF[(size_t)m * 512 + PF_CKV + 64 + I.lane];
        const float ssq = wave_sum(c0 * c0 + c1 * c1); const float r = 1.0f / sqrtf(ssq * (1.0f / 128.0f) + 1e-6f);
        const float n0 = c0 * r * g0, n1 = c1 * r * g1; float a0 = 0.f, a1 = 0.f;
#pragma unroll 8
        for (int k = 0; k < 64; ++k) { const float a = __shfl(n0, k); a0 += a * Wkv[k * 128 + I.lane]; a1 += a * Wkv[k * 128 + 64 + I.lane]; }
#pragma unroll 8
        for (int k = 0; k < 64; ++k) { const float a = __shfl(n1, k); a0 += a * Wkv[(64 + k) * 128 + I.lane]; a1 += a * Wkv[(64 + k) * 128 + 64 + I.lane]; }
        KC[(size_t)m * 64 + I.lane] = (bf16)f2bf(a0); VC[(size_t)m * 64 + I.lane] = (bf16)f2bf(a1);
    }
}
__device__ __forceinline__ void unpack8(const v4u w, float (&f)[8]) {
    f[0] = __uint_as_float(w.x << 16); f[1] = __uint_as_float(w.x & 0xffff0000u); f[2] = __uint_as_float(w.y << 16); f[3] = __uint_as_float(w.y & 0xffff0000u);
    f[4] = __uint_as_float(w.z << 16); f[5] = __uint_as_float(w.z & 0xffff0000u); f[6] = __uint_as_float(w.w << 16); f[7] = __uint_as_float(w.w & 0xffff0000u);
}
__device__ __forceinline__ void key_step(const v4u (&q)[8], const bf16* krow, const bf16* vrow, float bias, float& mrun, float& lsum, float (&o)[64]) {
    float dot = 0.f;
#pragma unroll
    for (int c = 0; c < 8; ++c) { const v4u kw = *(const GAS v4u*)(krow + 8 * c); float kf[8], qf[8]; unpack8(kw, kf); unpack8(q[c], qf);
#pragma unroll
        for (int e = 0; e < 8; ++e) dot += qf[e] * kf[e]; }
    const float sc = dot + bias, mn = fmaxf(mrun, sc), al = __builtin_amdgcn_exp2f(mrun - mn), p = __builtin_amdgcn_exp2f(sc - mn);
    lsum = lsum * al + p; mrun = mn;
#pragma unroll
    for (int c = 0; c < 8; ++c) { const v4u vw = *(const GAS v4u*)(vrow + 8 * c); float vf[8]; unpack8(vw, vf);
#pragma unroll
        for (int e = 0; e < 8; ++e) o[8 * c + e] = o[8 * c + e] * al + p * vf[e]; }
}
__device__ __forceinline__ void store_o(bf16* dst, const float (&o)[64], float inv) {
#pragma unroll
    for (int c = 0; c < 8; ++c) { v4u w; w.x = pk2(o[8 * c] * inv, o[8 * c + 1] * inv); w.y = pk2(o[8 * c + 2] * inv, o[8 * c + 3] * inv); w.z = pk2(o[8 * c + 4] * inv, o[8 * c + 5] * inv); w.w = pk2(o[8 * c + 6] * inv, o[8 * c + 7] * inv);
        *(GAS v4u*)(dst + 8 * c) = w; }
}
__device__ __forceinline__ void swa_naive(Frame& F, const Args& A, int l) {
    const Ids I = phase_ids();
    const bf16* P = (const bf16*)(A.ws + WS_ACT); bf16* ATT = (bf16*)(A.ws + WS_ATT);
    LAS float* biasA = (LAS float*)(F.lds);
    __syncthreads();
    for (int i = I.tid; i < 8 * 128; i += NWAVES * 64) { const int h = i >> 7, d = i & 127; biasA[i] = A.rbt[t5_bucket(d) * 16 + h] * LOG2E; }
    __syncthreads();
    for (int item = blockIdx.x * (NWAVES * 64) + I.tid; item < M * 8; item += F.G * NWAVES * 64) {
        const int h = item / M, m = item % M, t = m & (T - 1);
        v4u q[8];
#pragma unroll
        for (int c = 0; c < 8; ++c) q[c] = *(const GAS v4u*)(P + (size_t)m * NP + C_QA + h * 64 + 8 * c);
        float mrun = A.sinks[l * 8 + h] * LOG2E, lsum = 1.0f, o[64];
#pragma unroll
        for (int e = 0; e < 64; ++e) o[e] = 0.f;
        const int nk = (t + 1 < 128) ? (t + 1) : 128;
        for (int i = 0; i < nk; ++i) { const bf16* row = P + (size_t)(m - i) * NP + (h >> 2) * 64; key_step(q, row + C_KA, row + C_VA, biasA[h * 128 + i], mrun, lsum, o); }
        store_o(ATT + (size_t)m * D + h * 64, o, 1.0f / lsum);
    }
}
__device__ __forceinline__ void moba_naive(Frame& F, const Args& A) {
    const Ids I = phase_ids();
    const bf16* P = (const bf16*)(A.ws + WS_ACT); bf16* ATT = (bf16*)(A.ws + WS_ATT); const float* KMEAN = (const float*)(A.ws + WS_KMEAN);
    LAS float* biasB = (LAS float*)(F.lds);
    __syncthreads();
    for (int i = I.tid; i < 4 * 128; i += NWAVES * 64) { const int h = i >> 7, d = i & 127; biasB[i] = A.rbt[t5_bucket(d) * 16 + 8 + h] * LOG2E; }
    __syncthreads();
    for (int item = blockIdx.x * (NWAVES * 64) + I.tid; item < M * 4; item += F.G * NWAVES * 64) {
        const int h = item / M, m = item % M, b = m >> 13, t = m & (T - 1), own = t >> 8;
        v4u q[8];
#pragma unroll
        for (int c = 0; c < 8; ++c) q[c] = *(const GAS v4u*)(P + (size_t)m * NP + C_QB + h * 64 + 8 * c);
        float v0 = -INFINITY, v1 = -INFINITY, v2 = -INFINITY; int i0 = -1, i1 = -1, i2 = -1;
        for (int n = 0; n < own; ++n) { const float* km = KMEAN + ((size_t)((b * 4 + h) * 32 + n)) * 64; float g = 0.f;
#pragma unroll
            for (int c = 0; c < 8; ++c) { float qf[8]; unpack8(q[c], qf); const f32x4 ka = *(const GAS f32x4*)(km + 8 * c), kb = *(const GAS f32x4*)(km + 8 * c + 4);
                g += qf[0] * ka.x + qf[1] * ka.y + qf[2] * ka.z + qf[3] * ka.w + qf[4] * kb.x + qf[5] * kb.y + qf[6] * kb.z + qf[7] * kb.w; }
            if (g > v0) { v2 = v1; i2 = i1; v1 = v0; i1 = i0; v0 = g; i0 = n; } else if (g > v1) { v2 = v1; i2 = i1; v1 = g; i1 = n; } else if (g > v2) { v2 = g; i2 = n; } }
        float mrun = -1e30f, lsum = 0.f, o[64];
#pragma unroll
        for (int e = 0; e < 64; ++e) o[e] = 0.f;
        const size_t rb = (size_t)b * T;
        for (int s = own * 256; s <= t; ++s) { const bf16* row = P + (rb + s) * NP + h * 64; const int dd = t - s; key_step(q, row + C_KB, row + C_VB, biasB[h * 128 + (dd < 127 ? dd : 127)], mrun, lsum, o); }
        for (int j = 0; j < 3; ++j) { const int blk = (j == 0) ? i0 : (j == 1) ? i1 : i2; if (blk < 0) continue;
            for (int s = blk * 256; s < blk * 256 + 256; ++s) { const bf16* row = P + (rb + s) * NP + h * 64; const int dd = t - s; key_step(q, row + C_KB, row + C_VB, biasB[h * 128 + (dd < 127 ? dd : 127)], mrun, lsum, o); } }
        store_o(ATT + (size_t)m * D + 512 + h * 64, o, 1.0f / lsum);
    }
}
__device__ __forceinline__ unsigned fkey(float f) { unsigned u = __float_as_uint(f); if (u == 0x80000000u) u = 0u; return (u & 0x80000000u) ? ~u : (u | 0x80000000u); }
__device__ __forceinline__ void dsa_naive(Frame& F, const Args& A) {
    const Ids I = phase_ids();
    const bf16* P = (const bf16*)(A.ws + WS_ACT); const float* PF = (const float*)(A.ws + WS_PF); bf16* ATT = (bf16*)(A.ws + WS_ATT);
    const bf16* KC = (const bf16*)(A.ws + WS_KC); const bf16* VC = (const bf16*)(A.ws + WS_VC);
    LAS unsigned* KEYS = (LAS unsigned*)(F.lds);
    LAS float* QI = (LAS float*)(F.lds + 32768);
    LAS float* QC = (LAS float*)(F.lds + 33792);
    LAS float* PB = (LAS float*)(F.lds + 34816);
    LAS unsigned* LIST = (LAS unsigned*)(F.lds + 38912);
    LAS unsigned* HIST = (LAS unsigned*)(F.lds + 39936);
    LAS float* biasC = (LAS float*)(F.lds + 40960);
    LAS float* RED = (LAS float*)(F.lds + 43008);
    LAS unsigned* MS = (LAS unsigned*)(F.lds + 43264);
    LAS float* WQ = (LAS float*)(F.lds + 43328);
    const int tid = I.tid, lane = I.lane, wave = I.wave;
    __syncthreads();
    for (int i = tid; i < 4 * 128; i += NWAVES * 64) { const int h = i >> 7, d = i & 127; biasC[i] = A.rbt[t5_bucket(d) * 16 + 12 + h] * LOG2E; }
    for (int m = blockIdx.x; m < M; m += F.G) {
        const int b = m >> 13, t = m & (T - 1), nk = t + 1; const size_t rb = (size_t)b * T;
        __syncthreads();
        if (tid < 256) QI[tid] = PF[(size_t)m * 512 + PF_QIDX + tid] * 0.125f; else QC[tid - 256] = bf2f(P[(size_t)m * NP + C_QC + (tid - 256)]);
        if (tid < 4) WQ[tid] = PF[(size_t)m * 512 + PF_WIDX + tid] * 0.5f;
        __syncthreads();
        const float w0 = WQ[0], w1 = WQ[1], w2 = WQ[2], w3 = WQ[3];
        for (int s = tid; s < nk; s += NWAVES * 64) {
            const GAS f32x4* kr = (const GAS f32x4*)(PF + (rb + s) * 512 + PF_KIDX); const LAS f32x4* q4 = (const LAS f32x4*)QI;
            float d0 = 0.f, d1 = 0.f, d2 = 0.f, d3 = 0.f;
#pragma unroll 4
            for (int c = 0; c < 16; ++c) { const f32x4 k = kr[c]; const f32x4 a0 = q4[c], a1 = q4[16 + c], a2 = q4[32 + c], a3 = q4[48 + c];
                d0 += k.x * a0.x + k.y * a0.y + k.z * a0.z + k.w * a0.w; d1 += k.x * a1.x + k.y * a1.y + k.z * a1.z + k.w * a1.w;
                d2 += k.x * a2.x + k.y * a2.y + k.z * a2.z + k.w * a2.w; d3 += k.x * a3.x + k.y * a3.y + k.z * a3.z + k.w * a3.w; }
            float sc = fmaxf(d0, 0.f) * w0; sc += fmaxf(d1, 0.f) * w1; sc += fmaxf(d2, 0.f) * w2; sc += fmaxf(d3, 0.f) * w3;
            KEYS[s] = fkey(sc);
        }
        int nsel;
        if (nk <= 256) { if (tid < nk) LIST[tid] = (unsigned)tid; nsel = nk; __syncthreads(); }
        else {
            unsigned prefix = 0u, remaining = 256u;
            for (int pass = 3; pass >= 0; --pass) {
                __syncthreads();
                if (tid < 256) HIST[tid] = 0u;
                __syncthreads();
                const int shift = 8 * pass;
                for (int s = tid; s < nk; s += NWAVES * 64) { const unsigned key = KEYS[s]; const bool match = (pass == 3) || ((key >> (shift + 8)) == prefix);
                    if (match) __hip_atomic_fetch_add(&HIST[(key >> shift) & 255u], 1u, __ATOMIC_RELAXED, __HIP_MEMORY_SCOPE_WORKGROUP); }
                __syncthreads();
                if (wave == 0) {
                    const unsigned c0 = HIST[255 - 4 * lane], c1 = HIST[254 - 4 * lane], c2 = HIST[253 - 4 * lane], c3 = HIST[252 - 4 * lane], tot = c0 + c1 + c2 + c3;
                    unsigned incl = tot;
#pragma unroll
                    for (int o = 1; o < 64; o <<= 1) { const unsigned v = __shfl_up(incl, o); if (lane >= o) incl += v; }
                    const unsigned excl = incl - tot;
                    if (excl < remaining && remaining <= incl) { unsigned r = remaining - excl, digit;
                        if (r <= c0) digit = 255 - 4 * lane; else { r -= c0; if (r <= c1) digit = 254 - 4 * lane; else { r -= c1; if (r <= c2) digit = 253 - 4 * lane; else { r -= c2; digit = 252 - 4 * lane; } } }
                        MS[0] = (prefix << 8) | digit; MS[1] = r; }
                }
                __syncthreads();
                prefix = MS[0]; remaining = MS[1];
            }
            if (tid == 0) MS[2] = 0u;
            __syncthreads();
            const unsigned tk = prefix, r = remaining, ngt = 256u - r;
            for (int s = tid; s < nk; s += NWAVES * 64) if (KEYS[s] > tk) { const unsigned slot = __hip_atomic_fetch_add(&MS[2], 1u, __ATOMIC_RELAXED, __HIP_MEMORY_SCOPE_WORKGROUP); if (slot < 256u) LIST[slot] = (unsigned)s; }
            if (wave == 0) { unsigned base = 0u;
                for (int s0 = 0; s0 < nk && base < r; s0 += 64) { const int s = s0 + lane; const bool eq = (s < nk) && (KEYS[s] == tk); const unsigned long long mask = __ballot(eq);
                    const unsigned pos = base + (unsigned)__popcll(mask & ((1ull << lane) - 1ull)); if (eq && pos < r) LIST[ngt + pos] = (unsigned)s; base += (unsigned)__popcll(mask); } }
            nsel = 256; __syncthreads();
        }
        { const int h = tid >> 7, j = tid & 127; float sc2[2];
#pragma unroll
            for (int u = 0; u < 2; ++u) { const int jj = j + 128 * u; float sc = -INFINITY;
                if (jj < nsel) { const int s = (int)LIST[jj]; const bf16* krow = KC + (rb + s) * 64; float dot = 0.f;
#pragma unroll
                    for (int c = 0; c < 8; ++c) { const v4u kw = *(const GAS v4u*)(krow + 8 * c); float kf[8]; unpack8(kw, kf); const LAS f32x4* q4 = (const LAS f32x4*)(QC + h * 64 + 8 * c); const f32x4 qa = q4[0], qb = q4[1];
                        dot += kf[0] * qa.x + kf[1] * qa.y + kf[2] * qa.z + kf[3] * qa.w + kf[4] * qb.x + kf[5] * qb.y + kf[6] * qb.z + kf[7] * qb.w; }
                    const int dd = t - s; sc = dot + biasC[h * 128 + (dd < 127 ? dd : 127)]; }
                sc2[u] = sc; }
            const float wm = wave_max(fmaxf(sc2[0], sc2[1])); if (lane == 0) RED[wave] = wm;
            __syncthreads();
            const float hm = fmaxf(RED[2 * h], RED[2 * h + 1]);
            const float p0 = __builtin_amdgcn_exp2f(sc2[0] - hm), p1 = __builtin_amdgcn_exp2f(sc2[1] - hm);
            PB[h * 256 + j] = p0; PB[h * 256 + j + 128] = p1;
            const float ws_ = wave_sum(p0 + p1); if (lane == 0) RED[8 + wave] = ws_;
            __syncthreads();
        }
        if (tid < 256) { const int h = tid >> 6, d = tid & 63; float acc = 0.f;
            for (int jj = 0; jj < nsel; ++jj) acc += PB[h * 256 + jj] * bf2f(VC[(rb + LIST[jj]) * 64 + d]);
            const float lsum = RED[8 + 2 * h] + RED[8 + 2 * h + 1];
            ATT[(size_t)m * D + 768 + h * 64 + d] = (bf16)f2bf(acc / lsum); }
    }
    __syncthreads();
}
__device__ __forceinline__ void final_phase(Frame& F, const Args& A) {
    const Ids I = phase_ids();
    const float* SS = (const float*)(A.ws + WS_SS);
    const int gw = blockIdx.x * NWAVES + I.wave, NGW = F.G * NWAVES;
    f32x4 g[4];
#pragma unroll
    for (int j = 0; j < 4; ++j) g[j] = *((const GAS f32x4*)A.nf + I.lane + 64 * j);
    for (int m = gw; m < M; m += NGW) {
        const float r = pg8::row_rstd(SS, m);
        GAS f32x4* xr = (GAS f32x4*)(A.out + (size_t)m * D) + I.lane;
#pragma unroll
        for (int j = 0; j < 4; ++j) { f32x4 v = xr[64 * j]; v = v * r * g[j]; xr[64 * j] = v; }
    }
}
constexpr int N_PHASES = 18;
#ifndef EN_SWA
#define EN_SWA 1
#endif
#ifndef EN_MOBA
#define EN_MOBA 1
#endif
#ifndef EN_DSA
#define EN_DSA 1
#endif
#ifndef PHMASK
#define PHMASK 0x3ff
#endif
__global__ void __launch_bounds__(NWAVES * 64, 2) mega_fwd(Args args) {
    extern __shared__ __attribute__((aligned(16))) unsigned char lds[];
    Frame F;
    F.lds = (LAS unsigned char*)lds; F.MISC = (volatile LAS unsigned*)(F.lds + MISC_OFF);
    F.G = gridDim.x;
    unsigned char* ws = args.ws; F.ctl = (gu32*)(ws + WS_CTL);
    for (int u = threadIdx.x; u < (LDS_BYTES - LDSCTL_OFF) / 4; u += NWAVES * 64) ((LAS unsigned*)(F.lds + LDSCTL_OFF))[u] = 0u;
    __syncthreads();
    const int lo = args.ph_lo, hi = args.ph_hi;
    const bool multi = (hi - lo) > 1;
    XcdBarrier bar; bar.bar = (unsigned*)(F.ctl + CW_BAR); bar.x = 0; bar.st = nullptr;
    if (multi) bar = xcd_barrier_post((unsigned*)(F.ctl + CW_BAR), F.MISC + 8);
#define IN(k) (lo <= (k) && (k) < hi)
#define SEAM(k) do { if (IN(k) && IN((k) + 1)) xcd_barrier(bar); } while (0)
    bf16* XB = (bf16*)(ws + WS_XB); float* SS = (float*)(ws + WS_SS); bf16* ACT = (bf16*)(ws + WS_ACT); bf16* Pb = (bf16*)(ws + WS_ACT); float* PF = (float*)(ws + WS_PF); bf16* ATT = (bf16*)(ws + WS_ATT);
    if (((PHMASK >> 8) & 1) && IN(0)) { p0_prologue(F, args); }
    SEAM(0);
    for (int l = 0; l < DEPTH; ++l) {
        const int pb = 1 + 8 * l;
        unsigned char* wl = ws + WS_W + (size_t)l * W_LAYER;
        if (((PHMASK >> 0) & 1) && IN(pb + 0)) { pg8::Gemm g{XB, (const bf16*)(wl + WO_GU1), M, NGU, D}; pg8::StaticOrder S; S.init(M, NGU, F.G, (int)blockIdx.x);
            pg8::EpiSwiGLU E{ACT, FF, SS}; pg8::gemm_phase<pg8::EpiSwiGLU, pg8::StaticOrder, true, true>(F.lds + RING_OFF, g, S, E); }
        SEAM(pb + 0);
        if (((PHMASK >> 1) & 1) && IN(pb + 1)) { pg8::Gemm g{ACT, (const bf16*)(wl + WO_D1), M, D, FF}; pg8::StaticOrder S; S.init(M, D, F.G, (int)blockIdx.x);
            pg8::EpiResid E{(l == 0) ? args.x : (const float*)args.out, args.out, XB, SS, 0.5f}; pg8::gemm_phase<pg8::EpiResid, pg8::StaticOrder, true, true>(F.lds + RING_OFF, g, S, E); }
        SEAM(pb + 1);
        if (((PHMASK >> 2) & 1) && IN(pb + 2)) { pg8::Gemm g{XB, (const bf16*)(wl + WO_IN), M, NP, D}; pg8::StaticOrder S; S.init(M, NP, F.G, (int)blockIdx.x);
            pg8::EpiProj E{Pb, PF, SS, QSCALE}; pg8::gemm_phase<pg8::EpiProj, pg8::StaticOrder, true, true>(F.lds + RING_OFF, g, S, E); }
        SEAM(pb + 2);
        if (((PHMASK >> 3) & 1) && IN(pb + 3)) { prep_phase(F, args, l); }
        SEAM(pb + 3);
        if (((PHMASK >> 4) & 1) && IN(pb + 4)) {
#if EN_SWA
            swa_naive(F, args, l);
#endif
#if EN_MOBA
            moba_naive(F, args);
#endif
#if EN_DSA
            dsa_naive(F, args);
#endif
        }
        SEAM(pb + 4);
        if (((PHMASK >> 5) & 1) && IN(pb + 5)) { pg8::Gemm g{ATT, (const bf16*)(wl + WO_OUT), M, D, D}; pg8::StaticOrder S; S.init(M, D, F.G, (int)blockIdx.x);
            pg8::EpiResid E{(const float*)args.out, args.out, XB, SS, 1.0f}; pg8::gemm_phase<pg8::EpiResid, pg8::StaticOrder, true, true>(F.lds + RING_OFF, g, S, E); }
        SEAM(pb + 5);
        if (((PHMASK >> 6) & 1) && IN(pb + 6)) { pg8::Gemm g{XB, (const bf16*)(wl + WO_GU2), M, NGU, D}; pg8::StaticOrder S; S.init(M, NGU, F.G, (int)blockIdx.x);
            pg8::EpiSwiGLU E{ACT, FF, SS}; pg8::gemm_phase<pg8::EpiSwiGLU, pg8::StaticOrder, true, true>(F.lds + RING_OFF, g, S, E); }
        SEAM(pb + 6);
        if (((PHMASK >> 7) & 1) && IN(pb + 7)) { pg8::Gemm g{ACT, (const bf16*)(wl + WO_D2), M, D, FF}; pg8::StaticOrder S; S.init(M, D, F.G, (int)blockIdx.x);
            pg8::EpiResid E{(const float*)args.out, args.out, XB, SS, 0.5f}; pg8::gemm_phase<pg8::EpiResid, pg8::StaticOrder, true, true>(F.lds + RING_OFF, g, S, E); }
        SEAM(pb + 7);
    }
    if (((PHMASK >> 9) & 1) && IN(17)) { final_phase(F, args); }
#undef IN
#undef SEAM
}
#ifndef MK_ONE_LAUNCH
#define MK_ONE_LAUNCH 1
#endif
extern "C" void kernel_launch(void* const* d_in, const int* in_sizes, int n_in, void* d_out, int out_size, void* d_ws, size_t ws_size, hipStream_t stream) {
    static int grid = 0;
    if (grid == 0) {
        if (n_in != 17 || in_sizes[0] != M * D || out_size != M * D || ws_size < WS_END) { fprintf(stderr, "kernel_launch: unexpected shapes (n_in %d, in0 %d, out %d, ws %zu); nothing launched\n", n_in, n_in > 0 ? in_sizes[0] : -1, out_size, ws_size); grid = -1; return; }
        int dev = 0, cus = 0, per_cu = 0;
        if (hipGetDevice(&dev) != hipSuccess || hipDeviceGetAttribute(&cus, hipDeviceAttributeMultiprocessorCount, dev) != hipSuccess) { grid = -1; return; }
        if (hipFuncSetAttribute((const void*)mega_fwd, hipFuncAttributeMaxDynamicSharedMemorySize, LDS_BYTES) != hipSuccess) { fprintf(stderr, "kernel_launch: hipFuncSetAttribute failed\n"); grid = -1; return; }
        if (hipOccupancyMaxActiveBlocksPerMultiprocessor(&per_cu, (const void*)mega_fwd, NWAVES * 64, LDS_BYTES) != hipSuccess || per_cu < 1) { fprintf(stderr, "kernel_launch: occupancy query reports %d blocks per CU\n", per_cu); }
        (void)hipGetLastError();
        grid = cus;
    }
    if (grid < 0) return;
    if (hipMemsetAsync((char*)d_ws + WS_CTL, 0, CTL_ZERO_BYTES, stream) != hipSuccess) return;
    Args a{};
    a.x = (const float*)d_in[0]; a.rbt = (const float*)d_in[1]; a.n1 = (const float*)d_in[2]; a.g1 = (const float*)d_in[3]; a.u1 = (const float*)d_in[4]; a.d1 = (const float*)d_in[5];
    a.nm = (const float*)d_in[6]; a.win = (const float*)d_in[7]; a.sinks = (const float*)d_in[8]; a.kvn = (const float*)d_in[9]; a.wkv = (const float*)d_in[10]; a.wout = (const float*)d_in[11];
    a.n2 = (const float*)d_in[12]; a.g2 = (const float*)d_in[13]; a.u2 = (const float*)d_in[14]; a.d2 = (const float*)d_in[15]; a.nf = (const float*)d_in[16];
    a.out = (float*)d_out; a.ws = (unsigned char*)d_ws;
#if MK_ONE_LAUNCH
    a.ph_lo = 0; a.ph_hi = N_PHASES;
    hipLaunchKernelGGL(mega_fwd, dim3(grid), dim3(NWAVES * 64), LDS_BYTES, stream, a);
#else
    for (int p = 0; p < N_PHASES; ++p) { a.ph_lo = p; a.ph_hi = p + 1; hipLaunchKernelGGL(mega_fwd, dim3(grid), dim3(NWAVES * 64), LDS_BYTES, stream, a); }
#endif
}
```

```cpp
#include <hip/hip_runtime.h>
#include <cstdio>
#include <cstdint>
#include <cmath>
#ifndef PG8_WGM
#define PG8_WGM 8
#endif
namespace pg8 {
#define PG8_LAS __attribute__((address_space(3)))
typedef unsigned short bf16_t;
typedef short bf16x8 __attribute__((ext_vector_type(8)));
typedef float f32x4 __attribute__((ext_vector_type(4)));
typedef unsigned u32x4 __attribute__((ext_vector_type(4)));
constexpr int BM = 256, BK = 64, HALF = 128, HTB = HALF * BK * 2  , STAGE_BYTES = 8 * HTB, NXCD = 8, WGM = PG8_WGM;

__host__ __device__ __forceinline__ int lds_byte(int r, int c) { const int st = (r >> 4) * 2 + (c >> 5), rr = r & 15, cc = c & 31, ob = rr * 64 + cc * 2; return st * 1024 + (ob ^ (((ob >> 9) & 1) << 5)); }
__host__ __device__ __forceinline__ void stage_rc(int b, int& R, int& C) { const int st = b / 1024, sb = b % 1024, swz = sb ^ (((sb >> 9) & 1) << 5); R = (st >> 1) * 16 + swz / 64; C = (st & 1) * 32 + (swz % 64) / 2; }
__host__ __device__ __forceinline__ int perm32(int rho) { const int n = rho >> 4, i = rho & 15; return 8 * (i >> 2) + 4 * n + (i & 3); }

struct Unit { int pm, pn; };
struct Gemm { const bf16_t* A; const bf16_t* Bt; int M, N, K; };

struct StaticOrder {
    int nM, nN, nwg, G, c;
    __host__ __device__ void init(int M, int N, int G_, int c_) { nM = M / BM; nN = N / BM; nwg = nM * nN; G = G_; c = c_; }
    __host__ __device__ bool next(int i, Unit& u) const {
        const long L = (long)i * G + c; if (L >= nwg) return false;
        int wgid = (int)L; { const int q = nwg / NXCD, r = nwg % NXCD, xcd = wgid % NXCD, off = wgid / NXCD; wgid = (xcd < r ? xcd * (q + 1) : r * (q + 1) + (xcd - r) * q) + off; }
        const int nig = WGM * nN, gid = wgid / nig, fm = gid * WGM, gsz = (nM - fm) < WGM ? (nM - fm) : WGM;
        u.pm = fm + ((wgid % nig) % gsz); u.pn = (wgid % nig) / gsz; return true;
    }
    __device__ __forceinline__ void a_ready(const Unit&) const {}
    __device__ __forceinline__ void done(const Unit&) const {}
};

__device__ __forceinline__ unsigned cvt_pk_bf16(float lo, float hi) { unsigned r; asm volatile("v_cvt_pk_bf16_f32 %0, %1, %2" : "=v"(r) : "v"(lo), "v"(hi)); return r; }
typedef float f32x2 __attribute__((ext_vector_type(2)));
__device__ __forceinline__ float quad_rows_sum(float v) {
    const auto a = __builtin_amdgcn_permlane16_swap(__float_as_uint(v), __float_as_uint(v), false, false); v = __uint_as_float(a[0]) + __uint_as_float(a[1]);
    const auto b = __builtin_amdgcn_permlane32_swap(__float_as_uint(v), __float_as_uint(v), false, false); return __uint_as_float(b[0]) + __uint_as_float(b[1]);
}
__device__ __forceinline__ float row_rstd(const float* ss, int row) {
    const f32x4* p = (const f32x4*)(ss + (size_t)row * 16);
    const f32x4 a = p[0], b = p[1], c = p[2], d = p[3];
    const float s = (((a[0] + a[1]) + (a[2] + a[3])) + ((b[0] + b[1]) + (b[2] + b[3]))) + (((c[0] + c[1]) + (c[2] + c[3])) + ((d[0] + d[1]) + (d[2] + d[3])));
    return 1.0f / sqrtf(s * (1.0f / 1024.0f) + 1e-6f);
}
__device__ __forceinline__ void rows_rstd(const float* ss, int row0, int fq, float (&rs)[8]) {
    f32x4 v[8];
#pragma unroll
    for (int i = 0; i < 8; ++i) v[i] = *(const f32x4*)(ss + (size_t)(row0 + (i >> 2) * HALF + (i & 3) * 16) * 16 + 4 * fq);
#pragma unroll
    for (int i = 0; i < 8; ++i) { float s = (v[i][0] + v[i][1]) + (v[i][2] + v[i][3]); s = quad_rows_sum(s); rs[i] = __builtin_amdgcn_rsqf(s * (1.0f / 1024.0f) + 1e-6f);     }
}
__device__ __forceinline__ size_t tiled_off(int row, int col, int nc) { return ((size_t)(row >> 4) * (nc >> 5) + (col >> 5)) * 512 + (row & 15) * 32 + (col & 31); }
__device__ __forceinline__ float silu_mul(float g, float u) {
    const float e = __builtin_amdgcn_exp2f(g * -1.4426950408889634f);
    return g * __builtin_amdgcn_rcpf(1.0f + e) * u;
}
struct EpiSwiGLU {
    static constexpr bool PERM = true, AFTER_DRAIN = false;
    bf16_t* O; int ldc; const float* ss;
    typedef float f32x2 __attribute__((ext_vector_type(2)));
    static __device__ __forceinline__ unsigned swiglu_pair(f32x2 g, f32x2 u, float rneg, float ir2) {
        const f32x2 tt = g * rneg; f32x2 e; e.x = __builtin_amdgcn_exp2f(tt.x); e.y = __builtin_amdgcn_exp2f(tt.y);
        const f32x2 d = e * ir2 + ir2; f32x2 q; q.x = __builtin_amdgcn_rcpf(d.x); q.y = __builtin_amdgcn_rcpf(d.y);
        const f32x2 o = (g * u) * q; return cvt_pk_bf16(o.x, o.y);
    }
    __device__ __forceinline__ void operator()(const f32x4 (&acc)[2][2][4][2], const Unit& u, int wr, int wc, int fr, int fq) const {
        const int row0 = u.pm * BM + wr * 64 + fr;
        f32x4 v[8];
#pragma unroll
        for (int i = 0; i < 8; ++i) v[i] = *(const f32x4*)(ss + (size_t)(row0 + (i >> 2) * HALF + (i & 3) * 16) * 16 + 4 * fq);
        float rneg[8], ir2[8];
#pragma unroll
        for (int i = 0; i < 8; ++i) { float s = (v[i][0] + v[i][1]) + (v[i][2] + v[i][3]); s = quad_rows_sum(s); ir2[i] = s * (1.0f / 1024.0f) + 1e-6f; rneg[i] = __builtin_amdgcn_rsqf(ir2[i]) * -1.4426950408889634f; }
#pragma unroll
        for (int ai = 0; ai < 2; ++ai)
#pragma unroll
            for (int m = 0; m < 4; ++m) { const float rn = rneg[ai * 4 + m], iq = ir2[ai * 4 + m];
                const f32x4 g0 = acc[ai][0][m][0], g1 = acc[ai][0][m][1], u0 = acc[ai][1][m][0], u1 = acc[ai][1][m][1];
                u32x4 w; w.x = swiglu_pair((f32x2){g0[0], g0[1]}, (f32x2){u0[0], u0[1]}, rn, iq); w.y = swiglu_pair((f32x2){g0[2], g0[3]}, (f32x2){u0[2], u0[3]}, rn, iq);
                w.z = swiglu_pair((f32x2){g1[0], g1[1]}, (f32x2){u1[0], u1[1]}, rn, iq); w.w = swiglu_pair((f32x2){g1[2], g1[3]}, (f32x2){u1[2], u1[3]}, rn, iq);
                *(u32x4*)(O + ((size_t)(u.pm * 16 + wr * 4 + ai * 8 + m) * (ldc >> 5) + (u.pn * 4 + wc)) * 512 + (fr * 32 + 8 * fq)) = w; }
    }
};
struct EpiResid {
    static constexpr bool PERM = true, AFTER_DRAIN = false;
    const float* xin32; bf16_t* xb; float* ss; float alpha;
    __device__ __forceinline__ void operator()(const f32x4 (&acc)[2][2][4][2], const Unit& u, int wr, int wc, int fr, int fq) const {
        const int row0 = u.pm * BM + wr * 64 + fr, col0 = u.pn * BM + wc * 32 + 8 * fq;
#pragma unroll
        for (int ai = 0; ai < 2; ++ai) {
            f32x4 xa[4][2], xc[4][2];
#pragma unroll
            for (int m = 0; m < 4; ++m)
#pragma unroll
                for (int bj = 0; bj < 2; ++bj) { const size_t o2 = (size_t)(row0 + ai * HALF + m * 16) * 1024 + col0 + bj * HALF;
                    if (xin32) { xa[m][bj] = *(const f32x4*)(xin32 + o2); xc[m][bj] = *(const f32x4*)(xin32 + o2 + 4); }
                    else { const u32x4 xw = *(const u32x4*)(xb + ((size_t)(u.pm * 16 + wr * 4 + ai * 8 + m) * 32 + (u.pn * 8 + 4 * bj + wc)) * 512 + (fr * 32 + 8 * fq));
                        xa[m][bj] = (f32x4){__uint_as_float(xw.x << 16), __uint_as_float(xw.x & 0xffff0000u), __uint_as_float(xw.y << 16), __uint_as_float(xw.y & 0xffff0000u)};
                        xc[m][bj] = (f32x4){__uint_as_float(xw.z << 16), __uint_as_float(xw.z & 0xffff0000u), __uint_as_float(xw.w << 16), __uint_as_float(xw.w & 0xffff0000u)}; } }
            asm volatile("" ::: "memory");
#pragma unroll
            for (int m = 0; m < 4; ++m) { const int row = row0 + ai * HALF + m * 16; float sq = 0.f;
#pragma unroll
                for (int bj = 0; bj < 2; ++bj) { const size_t o2 = ((size_t)(u.pm * 16 + wr * 4 + ai * 8 + m) * 32 + (u.pn * 8 + 4 * bj + wc)) * 512 + (fr * 32 + 8 * fq);
                    const f32x4 o0 = xa[m][bj] + acc[ai][bj][m][0] * alpha, o1 = xc[m][bj] + acc[ai][bj][m][1] * alpha;
                    u32x4 w; w.x = cvt_pk_bf16(o0[0], o0[1]); w.y = cvt_pk_bf16(o0[2], o0[3]); w.z = cvt_pk_bf16(o1[0], o1[1]); w.w = cvt_pk_bf16(o1[2], o1[3]); *(u32x4*)(xb + o2) = w;
                    const float r0 = __uint_as_float(w.x << 16), r1 = __uint_as_float(w.x & 0xffff0000u), r2 = __uint_as_float(w.y << 16), r3 = __uint_as_float(w.y & 0xffff0000u);
                    const float r4 = __uint_as_float(w.z << 16), r5 = __uint_as_float(w.z & 0xffff0000u), r6 = __uint_as_float(w.w << 16), r7 = __uint_as_float(w.w & 0xffff0000u);
                    sq += ((r0 * r0 + r1 * r1) + (r2 * r2 + r3 * r3)) + ((r4 * r4 + r5 * r5) + (r6 * r6 + r7 * r7)); }
                sq = quad_rows_sum(sq);
                if (fq == 0) ss[(size_t)row * 16 + u.pn * 4 + wc] = sq; }
            asm volatile("" ::: "memory");
        }
    }
};
struct EpiProj {
    static constexpr bool PERM = true, AFTER_DRAIN = false;
    bf16_t* P; float* PF; const float* ss; float qscale; _Float16* QIH; _Float16* KIH;
    __device__ __forceinline__ void operator()(const f32x4 (&acc)[2][2][4][2], const Unit& u, int wr, int wc, int fr, int fq) const {
        const int row0 = u.pm * BM + wr * 64 + fr, col0 = u.pn * BM + wc * 32 + 8 * fq;
        const float sc = (u.pn <= 1 || u.pn == 3 || u.pn == 6) ? qscale : 1.0f;
        float rs[8]; rows_rstd(ss, row0, fq, rs);
#pragma unroll
        for (int ai = 0; ai < 2; ++ai)
#pragma unroll
            for (int m = 0; m < 4; ++m) { const int row = row0 + ai * HALF + m * 16; const float r = rs[ai * 4 + m] * sc;
#pragma unroll
                for (int bj = 0; bj < 2; ++bj) { const f32x4 v0 = acc[ai][bj][m][0] * r, v1 = acc[ai][bj][m][1] * r;
                    u32x4 w; w.x = cvt_pk_bf16(v0[0], v0[1]); w.y = cvt_pk_bf16(v0[2], v0[3]); w.z = cvt_pk_bf16(v1[0], v1[1]); w.w = cvt_pk_bf16(v1[2], v1[3]);
                    *(u32x4*)(P + (size_t)row * 2304 + col0 + bj * HALF) = w;
                    if (u.pn >= 7) { const int pc = (col0 - 1792) + bj * HALF;
                        float* pf = PF + (size_t)row * 512 + pc; *(f32x4*)pf = v0; *(f32x4*)(pf + 4) = v1;
                        if (pc >= 128 && pc < 448) { typedef _Float16 h8 __attribute__((ext_vector_type(8))); const float hs = pc < 384 ? 0.125f : 1.0f;
                            h8 o; o[0] = (_Float16)(v0[0] * hs); o[1] = (_Float16)(v0[1] * hs); o[2] = (_Float16)(v0[2] * hs); o[3] = (_Float16)(v0[3] * hs); o[4] = (_Float16)(v1[0] * hs); o[5] = (_Float16)(v1[1] * hs); o[6] = (_Float16)(v1[2] * hs); o[7] = (_Float16)(v1[3] * hs);
                            if (pc < 384) *(h8*)(QIH + (size_t)row * 256 + (pc - 128)) = o;
                            else *(h8*)(KIH + ((((size_t)(row >> 5)) * 8 + ((pc - 384) >> 3)) * 32 + (row & 31)) * 8) = o; } } } }
    }
};
template <class Epi, class Sched, bool ALIGN_EPI = false, bool SP2 = false, bool ATILED = false>
__device__ __forceinline__ void gemm_phase(PG8_LAS unsigned char* lds, const Gemm g, const Sched& S, const Epi& E) {
    int tid_ = threadIdx.x; asm volatile("" : "+v"(tid_));
    float zz_ = 0.f; asm volatile("" : "+v"(zz_));
    const int tid = tid_, wid = __builtin_amdgcn_readfirstlane(tid >> 6), lane = tid & 63, wr = wid >> 2, wc = wid & 3, fr = lane & 15, fq = lane >> 4;
    const int K = g.K, nt = K / BK;
    unsigned voffA, voffB;
    { int R, C; stage_rc(tid * 16, R, C); const int Rb = Epi::PERM ? ((R & ~31) + perm32(R & 31)) : R; voffB = (unsigned)(Rb * K + C) * 2u;
      voffA = ATILED ? (unsigned)((((R >> 4) * (K >> 5) + (C >> 5)) * 512 + (R & 15) * 32 + (C & 31)) * 2) : (unsigned)(R * K + C) * 2u; }
    const size_t qstep = (size_t)64 * K * 2;
    const size_t kstep = (size_t)(BK * 2);
    const size_t kstepA = ATILED ? (size_t)2048 : kstep;
    const size_t hstep = (size_t)HALF * K * 2;
    const size_t tstep = 2 * hstep;
    const unsigned ldsw = (unsigned)wid * 1024u;
    const int aoff = lds_byte(wr * 64 + fr, fq * 8), boff = lds_byte(wc * 32 + fr, fq * 8);
#define PG8_SA(b, h) (((b) * 2 + (h)) * HTB)
#define PG8_SB(b, h) ((4 + (b) * 2 + (h)) * HTB)
#define PG8_STAGE(bufoff, gbase, voff) do { _Pragma("unroll") for (int _i = 0; _i < 2; ++_i) \
        __builtin_amdgcn_global_load_lds((const unsigned*)((const char*)(gbase) + _i * qstep + (voff)), (PG8_LAS unsigned*)(lds + (bufoff) + ldsw + _i * 8192), 16, 0, 0); } while (0)
#define PG8_LDA(dst, b, h) do { _Pragma("unroll") for (int m = 0; m < 4; ++m) _Pragma("unroll") for (int k = 0; k < 2; ++k) dst[m][k] = *(const PG8_LAS bf16x8*)(lds + PG8_SA(b, h) + aoff + m * 2048 + k * 1024); } while (0)
#define PG8_LDB(dst, b, h) do { _Pragma("unroll") for (int n = 0; n < 2; ++n) _Pragma("unroll") for (int k = 0; k < 2; ++k) dst[n][k] = *(const PG8_LAS bf16x8*)(lds + PG8_SB(b, h) + boff + n * 2048 + k * 1024); } while (0)
#define PG8_MMA(ai, bj, At, Bt) do { __builtin_amdgcn_s_setprio(1); _Pragma("unroll") for (int m = 0; m < 4; ++m) _Pragma("unroll") for (int n = 0; n < 2; ++n) _Pragma("unroll") for (int k = 0; k < 2; ++k) \
        acc[ai][bj][m][n] = __builtin_amdgcn_mfma_f32_16x16x32_bf16(Bt[n][k], At[m][k], acc[ai][bj][m][n], 0, 0, 0); __builtin_amdgcn_s_setprio(0); } while (0)
#define PG8_WAIT_V(n) asm volatile("s_waitcnt vmcnt(" #n ")" ::: "memory")
#define PG8_WAIT_L(n) asm volatile("s_waitcnt lgkmcnt(" #n ")" ::: "memory")
#define PG8_BAR __builtin_amdgcn_s_barrier()
#define PG8_SCHED __builtin_amdgcn_sched_barrier(0)
    Unit cur, nxt; int ui = 0;
    if (!S.next(0, cur)) return;
    f32x4 acc[2][2][4][2];
#pragma unroll
    for (int a = 0; a < 2; ++a)
#pragma unroll
        for (int b = 0; b < 2; ++b)
#pragma unroll
            for (int m = 0; m < 4; ++m)
#pragma unroll
                for (int n = 0; n < 2; ++n) acc[a][b][m][n] = (f32x4){zz_, zz_, zz_, zz_};
    bf16x8 At[4][2], B0[2][2], B1[2][2];
    const char* cA = (const char*)g.A + (size_t)cur.pm * tstep; const char* cB = (const char*)g.Bt + (size_t)cur.pn * tstep;
    S.a_ready(cur);
    if constexpr (SP2) {
        PG8_STAGE(PG8_SB(0, 0), cB, voffB); PG8_STAGE(PG8_SB(0, 1), cB + hstep, voffB); PG8_STAGE(PG8_SA(0, 0), cA, voffA); PG8_STAGE(PG8_SA(0, 1), cA + hstep, voffA);
        if (wr == 1) PG8_BAR;
        PG8_WAIT_V(2); PG8_BAR;
        PG8_STAGE(PG8_SB(1, 0), cB + kstep, voffB); PG8_STAGE(PG8_SA(1, 0), cA + kstepA, voffA); PG8_STAGE(PG8_SB(1, 1), cB + hstep + kstep, voffB);
        PG8_WAIT_V(6); PG8_BAR;
    } else {
        PG8_STAGE(PG8_SB(0, 0), cB, voffB); PG8_STAGE(PG8_SA(0, 0), cA, voffA); PG8_STAGE(PG8_SB(0, 1), cB + hstep, voffB); PG8_STAGE(PG8_SA(0, 1), cA + hstep, voffA);
        if (wr == 1) PG8_BAR;
        PG8_WAIT_V(4); PG8_BAR;
        PG8_STAGE(PG8_SB(1, 0), cB + kstep, voffB); PG8_STAGE(PG8_SA(1, 0), cA + kstepA, voffA); PG8_STAGE(PG8_SB(1, 1), cB + hstep + kstep, voffB);
        PG8_WAIT_V(6); PG8_BAR;
    }
    for (;;) {
        const bool has_next = S.next(ui + 1, nxt);
        const char* nA = has_next ? (const char*)g.A + (size_t)nxt.pm * tstep : cA; const char* nB = has_next ? (const char*)g.Bt + (size_t)nxt.pn * tstep : cB;
        for (int t = 0; t < nt; t += 2) {
            const bool last = (t == nt - 2);
            const char* a1 = cA + (size_t)(t + 1) * kstepA;
            const char* a2 = last ? nA : cA + (size_t)(t + 2) * kstepA; const char* b2 = last ? nB : cB + (size_t)(t + 2) * kstep;
            const char* a3 = a2 + kstepA; const char* b3 = b2 + kstep;
            if (last && has_next) S.a_ready(nxt);
            if constexpr (SP2) {
            PG8_LDB(B0, 0, 0); PG8_LDB(B1, 0, 1); PG8_SCHED; PG8_LDA(At, 0, 0); PG8_STAGE(PG8_SA(1, 1), a1 + hstep, voffA);
            PG8_WAIT_V(8); PG8_WAIT_L(0); PG8_BAR; PG8_MMA(0, 0, At, B0); PG8_MMA(0, 1, At, B1); PG8_BAR; PG8_SCHED;
            PG8_LDA(At, 0, 1); PG8_STAGE(PG8_SB(0, 0), b2, voffB); PG8_STAGE(PG8_SB(0, 1), b2 + hstep, voffB); PG8_STAGE(PG8_SA(0, 0), a2, voffA);
            PG8_WAIT_V(8); PG8_WAIT_L(0); PG8_BAR; PG8_MMA(1, 0, At, B0); PG8_MMA(1, 1, At, B1); PG8_BAR; PG8_SCHED;
            PG8_LDB(B0, 1, 0); PG8_LDB(B1, 1, 1); PG8_SCHED; PG8_LDA(At, 1, 0); PG8_STAGE(PG8_SA(0, 1), a2 + hstep, voffA);
            PG8_WAIT_V(8); PG8_WAIT_L(0); PG8_BAR; PG8_MMA(0, 0, At, B0); PG8_MMA(0, 1, At, B1); PG8_BAR; PG8_SCHED;
            PG8_LDA(At, 1, 1); PG8_STAGE(PG8_SB(1, 0), b3, voffB); PG8_STAGE(PG8_SB(1, 1), b3 + hstep, voffB); PG8_STAGE(PG8_SA(1, 0), a3, voffA);
            PG8_WAIT_V(8); PG8_WAIT_L(0); PG8_BAR; PG8_MMA(1, 0, At, B0); PG8_MMA(1, 1, At, B1); PG8_BAR; PG8_SCHED;
            } else {
            PG8_LDB(B0, 0, 0); PG8_SCHED; PG8_LDA(At, 0, 0); PG8_STAGE(PG8_SA(1, 1), a1 + hstep, voffA);
            PG8_WAIT_L(8); PG8_BAR; PG8_WAIT_L(0); PG8_MMA(0, 0, At, B0); PG8_BAR; PG8_SCHED;
            PG8_LDB(B1, 0, 1); PG8_STAGE(PG8_SB(0, 0), b2, voffB);
            PG8_BAR; PG8_WAIT_L(0); PG8_MMA(0, 1, At, B1); PG8_BAR;
            PG8_LDA(At, 0, 1); PG8_STAGE(PG8_SA(0, 0), a2, voffA);
            PG8_BAR; PG8_WAIT_L(0); PG8_MMA(1, 0, At, B0); PG8_BAR; PG8_SCHED;
            PG8_STAGE(PG8_SB(0, 1), b2 + hstep, voffB);
            PG8_WAIT_V(6); PG8_BAR; PG8_MMA(1, 1, At, B1); PG8_BAR;
            PG8_LDB(B0, 1, 0); PG8_SCHED; PG8_LDA(At, 1, 0); PG8_STAGE(PG8_SA(0, 1), a2 + hstep, voffA);
            PG8_WAIT_L(8); PG8_BAR; PG8_WAIT_L(0); PG8_MMA(0, 0, At, B0); PG8_BAR; PG8_SCHED;
            PG8_LDB(B1, 1, 1); PG8_STAGE(PG8_SB(1, 0), b3, voffB);
            PG8_BAR; PG8_WAIT_L(0); PG8_MMA(0, 1, At, B1); PG8_BAR;
            PG8_LDA(At, 1, 1); PG8_STAGE(PG8_SA(1, 0), a3, voffA);
            PG8_BAR; PG8_WAIT_L(0); PG8_MMA(1, 0, At, B0); PG8_BAR; PG8_SCHED;
            PG8_STAGE(PG8_SB(1, 1), b3 + hstep, voffB);
            PG8_WAIT_V(6); PG8_BAR; PG8_MMA(1, 1, At, B1); PG8_BAR;
            }
        }
        if constexpr (ALIGN_EPI) { if (wr == 0) PG8_BAR; }
        if constexpr (!Epi::AFTER_DRAIN) { E(acc, cur, wr, wc, fr, fq); S.done(cur); }
        if (!has_next) break;
#pragma unroll
        for (int a = 0; a < 2; ++a)
#pragma unroll
            for (int b = 0; b < 2; ++b)
#pragma unroll
                for (int m = 0; m < 4; ++m)
#pragma unroll
                    for (int n = 0; n < 2; ++n) acc[a][b][m][n] = (f32x4){zz_, zz_, zz_, zz_};
        cur = nxt; cA = nA; cB = nB; ++ui;
        if constexpr (ALIGN_EPI) { if (wr == 1) PG8_BAR; }
    }
    PG8_WAIT_V(0);
    if constexpr (!ALIGN_EPI) { if (wr == 0) PG8_BAR; }
    PG8_BAR;
    if constexpr (Epi::AFTER_DRAIN) { E.fused(acc, cur, wr, wc, fr, fq, lds, wid, lane); S.done(cur); }
#undef PG8_SA
#undef PG8_SB
#undef PG8_STAGE
#undef PG8_LDA
#undef PG8_LDB
#undef PG8_MMA
#undef PG8_WAIT_V
#undef PG8_WAIT_L
#undef PG8_BAR
#undef PG8_SCHED
}
}
#define GAS __attribute__((address_space(1)))
#define LAS __attribute__((address_space(3)))
typedef unsigned short bf16;
typedef unsigned v4u __attribute__((ext_vector_type(4)));
typedef float f32x4 __attribute__((ext_vector_type(4)));
typedef short bf16x8 __attribute__((ext_vector_type(8)));
typedef GAS unsigned gu32;
typedef GAS unsigned long long gu64;
#define RLX_AGENT __ATOMIC_RELAXED, __HIP_MEMORY_SCOPE_AGENT
#define LDS_WAIT() asm volatile("s_waitcnt lgkmcnt(0)" ::: "memory")
#define VM_WAIT() asm volatile("s_waitcnt vmcnt(0)" ::: "memory")
__device__ __forceinline__ unsigned long long rt() { return __builtin_amdgcn_s_memrealtime(); }
__device__ __forceinline__ unsigned f2bf(float f) { unsigned u = __builtin_bit_cast(unsigned, f); return (u + 0x7fffu + ((u >> 16) & 1u)) >> 16; }
__device__ __forceinline__ unsigned pk2(float lo, float hi) { return f2bf(lo) | (f2bf(hi) << 16); }

__device__ __forceinline__ int hw_lane() { return (int)__builtin_amdgcn_mbcnt_hi(~0u, __builtin_amdgcn_mbcnt_lo(~0u, 0u)); }
#define hw_tid() (WAVE_IN_WG * 64 + hw_lane())
#define XB_TMO      128
#define XB_XCNT(j)  (256  + 64 * (j))
#define XB_XSUB(j)  (1280 + 64 * (j))
#define XB_XGEN(j)  (2304 + 64 * (j))
#define XB_TOP      3328
#define XB_TOPGEN   3392
#define XCD_BAR_WORDS 3456
#define XB_SPIN_CAP (1u << 18)

__device__ __forceinline__ unsigned xb_ld(unsigned* p)              { return __hip_atomic_load(p, __ATOMIC_RELAXED, __HIP_MEMORY_SCOPE_AGENT); }
__device__ __forceinline__ unsigned xb_add(unsigned* p, unsigned v) { return __hip_atomic_fetch_add(p, v, __ATOMIC_RELAXED, __HIP_MEMORY_SCOPE_AGENT); }
__device__ __forceinline__ unsigned xb_xcc_id() { return (unsigned)__builtin_amdgcn_s_getreg((3 << 11) | 20) & 0xFu; }
#define XB_SPIN(cond, bar) do { unsigned _sp = 0; while (cond) { __builtin_amdgcn_s_sleep(1); \
    if ((++_sp & 255u) == 0u) { if (xb_ld(&(bar)[XB_TMO])) break; if (_sp > XB_SPIN_CAP) { atomicAdd(&(bar)[XB_TMO], 1u); break; } } } } while (0)

struct XcdBarrier {
    unsigned* bar; unsigned x;
    volatile LAS unsigned* st;
};

__device__ __forceinline__ XcdBarrier xcd_barrier_post(unsigned* bar, volatile LAS unsigned* st) {
    XcdBarrier b; b.bar = bar; b.x = xb_xcc_id(); b.st = st;
    if (threadIdx.x == 0) (void)xb_add(&bar[XB_XCNT(b.x)], 1u);
    return b;
}
__device__ __forceinline__ void xcd_barrier_complete(unsigned* bar, unsigned x, unsigned& nloc, unsigned& nx) {
    const unsigned G = gridDim.x * gridDim.y * gridDim.z;
    unsigned sum, cnt, mine, sp = 0u;
    for (;;) {
        sum = 0u; cnt = 0u; mine = 0u;
#pragma unroll
        for (unsigned j = 0; j < 16; ++j) { const unsigned c = xb_ld(&bar[XB_XCNT(j)]); sum += c; cnt += (c > 0u) ? 1u : 0u; mine = (j == x) ? c : mine; }
        if (sum == G) break;
        __builtin_amdgcn_s_sleep(1);
        if ((++sp & 255u) == 0u) { if (xb_ld(&bar[XB_TMO])) break; if (sp > XB_SPIN_CAP) { atomicAdd(&bar[XB_TMO], 1u); break; } }
    }
    nloc = mine > 0u ? mine : 1u; nx = cnt > 0u ? cnt : 1u;
}

__device__ __forceinline__ void xcd_barrier(const XcdBarrier& b) {
    asm volatile("s_waitcnt vmcnt(0)" ::: "memory");
    __syncthreads();
    if (threadIdx.x == 0) {
        unsigned* bar = b.bar;
        __builtin_amdgcn_s_waitcnt(0);
        unsigned nloc = b.st[0], nx = b.st[1];
        if (nloc == 0u) { xcd_barrier_complete(bar, b.x, nloc, nx); b.st[0] = nloc; b.st[1] = nx; }
        const unsigned old = xb_add(&bar[XB_XSUB(b.x)], 1u);
        const unsigned gen = old / nloc;
        if (old + 1u == (gen + 1u) * nloc) {
            __builtin_amdgcn_fence(__ATOMIC_RELEASE, "agent");
            asm volatile("s_waitcnt vmcnt(0)" ::: "memory");
            const unsigned og = xb_add(&bar[XB_TOP], 1u);
            const unsigned tg = og / nx;
            if (og + 1u == (tg + 1u) * nx) xb_add(&bar[XB_TOPGEN], 1u);
            else XB_SPIN(xb_ld(&bar[XB_TOPGEN]) == tg, bar);
            __builtin_amdgcn_fence(__ATOMIC_ACQUIRE, "agent");
            xb_add(&bar[XB_XGEN(b.x)], 1u);
            asm volatile("s_waitcnt vmcnt(0)" ::: "memory");
        } else {
            XB_SPIN(xb_ld(&bar[XB_XGEN(b.x)]) == gen, bar);
            __builtin_amdgcn_fence(__ATOMIC_ACQUIRE, "agent");
            asm volatile("s_waitcnt vmcnt(0)" ::: "memory");
        }
    }
    __syncthreads();
}

constexpr int NWAVES = 8;
constexpr int BATCH = 4, T = 8192, D = 1024, M = BATCH * T, FF = 2816, NGU = 2 * FF, DIN = 2244, NP = 2304, DEPTH = 2;
constexpr int C_QA = 0, C_KA = 512, C_VA = 640, C_QB = 768, C_KB = 1024, C_VB = 1280, C_QC = 1536;
constexpr int PF_CKV = 0, PF_QIDX = 128, PF_KIDX = 384, PF_WIDX = 448;
constexpr float LOG2E = 1.4426950408889634f, QSCALE = 0.125f * LOG2E;
constexpr size_t MiB = 1u << 20;
constexpr size_t WS_CTL = 0, CTL_ZERO_BYTES = 1 * MiB;
constexpr size_t WS_W = 2 * MiB, W_LAYER = 40 * MiB;
constexpr size_t WO_GU1 = 0, WO_D1 = 11 * MiB, WO_IN = 16 * MiB + MiB / 2, WO_OUT = 21 * MiB, WO_GU2 = 23 * MiB, WO_D2 = 34 * MiB;
constexpr size_t WS_SS = 82 * MiB, WS_KMEAN = 84 * MiB, WS_KC = 85 * MiB, WS_VC = 89 * MiB;
constexpr size_t WS_XB = 96 * MiB, WS_ATT = 160 * MiB, WS_PF = 224 * MiB, WS_ACT = 288 * MiB, WS_QIH = 464 * MiB, WS_KIH = 480 * MiB, WS_LISTG = 484 * MiB, WS_END = 500 * MiB;
static_assert(WO_D2 + (size_t)D * FF * 2 <= W_LAYER && WS_W + 2 * W_LAYER <= WS_SS && WS_ACT + (size_t)M * FF * 2 <= WS_QIH, "ws map");
constexpr int CW_BAR = 4096;
constexpr int RING_OFF = 0, RING_BYTES = 131072;
constexpr int LDS_BYTES = 163840;
constexpr int LDSCTL_OFF = LDS_BYTES - 512, MISC_OFF = LDSCTL_OFF + 320;

struct Args {
    const float* x; const float* rbt; const float* n1; const float* g1; const float* u1; const float* d1; const float* nm; const float* win; const float* sinks; const float* kvn; const float* wkv;
    const float* wout; const float* n2; const float* g2; const float* u2; const float* d2; const float* nf; float* out; unsigned char* ws; int ph_lo, ph_hi;
};
typedef const Args __attribute__((address_space(4)))* ArgsCP;
__device__ __forceinline__ Args load_args(ArgsCP p) { Args a; a.x = p->x; a.rbt = p->rbt; a.n1 = p->n1; a.g1 = p->g1; a.u1 = p->u1; a.d1 = p->d1; a.nm = p->nm; a.win = p->win; a.sinks = p->sinks; a.kvn = p->kvn; a.wkv = p->wkv;
    a.wout = p->wout; a.n2 = p->n2; a.g2 = p->g2; a.u2 = p->u2; a.d2 = p->d2; a.nf = p->nf; a.out = p->out; a.ws = p->ws; a.ph_lo = p->ph_lo; a.ph_hi = p->ph_hi; return a; }
#define LOAD_ARGS(A, kp) ArgsCP kp_##A = (kp); asm volatile("" : "+s"(kp_##A)); const Args A = load_args(kp_##A)
struct Frame {
    LAS unsigned char* lds; volatile LAS unsigned* MISC; gu32* ctl;
    int G, wv, vb;
};
struct Ids { int tid, lane, wave; };
__device__ __forceinline__ Ids phase_ids() { int t = threadIdx.x; asm volatile("" : "+v"(t)); Ids I; I.tid = t; I.lane = t & 63; I.wave = __builtin_amdgcn_readfirstlane(t >> 6); return I; }
__device__ __forceinline__ float bf2f(unsigned h) { return __uint_as_float(h << 16); }
__device__ __forceinline__ float wave_sum(float v) {
#pragma unroll
    for (int o = 1; o < 64; o <<= 1) v += __shfl_xor(v, o);
    return v;
}
__device__ __forceinline__ float wave_max(float v) {
#pragma unroll
    for (int o = 1; o < 64; o <<= 1) v = fmaxf(v, __shfl_xor(v, o));
    return v;
}
__device__ __forceinline__ unsigned wave_scan_incl(unsigned x) {
    x += (unsigned)__builtin_amdgcn_update_dpp(0, (int)x, 0x111, 0xf, 0xf, true);
    x += (unsigned)__builtin_amdgcn_update_dpp(0, (int)x, 0x112, 0xf, 0xf, true);
    x += (unsigned)__builtin_amdgcn_update_dpp(0, (int)x, 0x114, 0xf, 0xf, true);
    x += (unsigned)__builtin_amdgcn_update_dpp(0, (int)x, 0x118, 0xf, 0xf, true);
    x += (unsigned)__builtin_amdgcn_update_dpp(0, (int)x, 0x142, 0xa, 0xf, false);
    x += (unsigned)__builtin_amdgcn_update_dpp(0, (int)x, 0x143, 0xc, 0xf, false);
    return x;
}
__device__ __forceinline__ float xor32_max(float v) { const auto r = __builtin_amdgcn_permlane32_swap(__float_as_uint(v), __float_as_uint(v), false, false); return fmaxf(__uint_as_float(r[0]), __uint_as_float(r[1])); }
__device__ __forceinline__ float xor32_sum(float v) { const auto r = __builtin_amdgcn_permlane32_swap(__float_as_uint(v), __float_as_uint(v), false, false); return __uint_as_float(r[0]) + __uint_as_float(r[1]); }
__device__ __forceinline__ float xor16_max(float v) { const auto r = __builtin_amdgcn_permlane16_swap(__float_as_uint(v), __float_as_uint(v), false, false); return fmaxf(__uint_as_float(r[0]), __uint_as_float(r[1])); }
__device__ __forceinline__ float xor16_sum(float v) { const auto r = __builtin_amdgcn_permlane16_swap(__float_as_uint(v), __float_as_uint(v), false, false); return __uint_as_float(r[0]) + __uint_as_float(r[1]); }
__device__ __forceinline__ int t5_bucket(int n) {
    if (n < 16) return n;
    int b = 16;
    b += (n >= 19); b += (n >= 21); b += (n >= 24); b += (n >= 27); b += (n >= 31); b += (n >= 35); b += (n >= 40); b += (n >= 46);
    b += (n >= 52); b += (n >= 59); b += (n >= 67); b += (n >= 77); b += (n >= 87); b += (n >= 99); b += (n >= 113);
    return b;
}
struct TrDesc { const float* W; const float* gain; bf16* WT; int K, N, mode, k0, n0; };
__device__ __forceinline__ TrDesc tr_desc(const float* W, int K, int N, bf16* WT, const float* gain, int mode, int item, int nblk) {
    TrDesc d; d.W = W; d.gain = gain; d.WT = WT; d.K = K; d.N = N; d.mode = mode; d.k0 = 64 * (item / nblk); d.n0 = 32 * (item % nblk); return d; }
__device__ __forceinline__ void tr_load(const TrDesc& d, int lane, float (&w)[32], f32x4 (&g)[2]) {
    const int nn = d.n0 + (lane & 31);
#pragma unroll
    for (int i = 0; i < 32; ++i) { const int kk = 2 * i + (lane >> 5); w[i] = (nn < d.N) ? d.W[(size_t)(d.k0 + kk) * d.N + nn] : 0.f; }
    if (d.gain) { const GAS f32x4* gp = (const GAS f32x4*)(d.gain + d.k0 + 8 * (lane & 7)); g[0] = gp[0]; g[1] = gp[1]; } else { g[0] = (f32x4){1.f, 1.f, 1.f, 1.f}; g[1] = g[0]; }
}
__device__ __forceinline__ void tr_finish(const TrDesc& d, int lane, const float (&w)[32], const f32x4 (&g)[2], LAS float* scr) {
#pragma unroll
    for (int i = 0; i < 32; ++i) { const int kk = 2 * i + (lane >> 5); scr[kk * 33 + (lane & 31)] = w[i]; }
    LDS_WAIT(); asm volatile("" ::: "memory");
    const int c = lane & 7;
    const int orow0 = (d.mode == 0) ? d.n0 : (256 * (d.n0 >> 7) + (d.n0 & 127) + (d.mode == 2 ? 128 : 0));
#pragma unroll
    for (int j = 0; j < 4; ++j) { const int n = (lane >> 3) + 8 * j; const LAS float* s = scr + (8 * c) * 33 + n;
        v4u o; o.x = pk2(s[0 * 33] * g[0][0], s[1 * 33] * g[0][1]); o.y = pk2(s[2 * 33] * g[0][2], s[3 * 33] * g[0][3]); o.z = pk2(s[4 * 33] * g[1][0], s[5 * 33] * g[1][1]); o.w = pk2(s[6 * 33] * g[1][2], s[7 * 33] * g[1][3]);
        *(GAS v4u*)(d.WT + (size_t)(orow0 + n) * d.K + d.k0 + 8 * c) = o; }
    LDS_WAIT(); asm volatile("" ::: "memory");
}
__device__ __forceinline__ void p0_prologue(Frame& F, ArgsCP kp) {
    LOAD_ARGS(A, kp);
    const Ids I = phase_ids();
    LAS float* scr = (LAS float*)(F.lds + RING_OFF + I.wave * 16384);
    const int gw = blockIdx.x * NWAVES + I.wave, NGW = F.G * NWAVES;
    constexpr int I_GU = (D / 64) * (FF / 32), I_DN = (FF / 64) * (D / 32), I_IN = (D / 64) * (NP / 32), I_OUT = (D / 64) * (D / 32);
    constexpr int PER_LAYER = 3 * I_GU + 3 * I_DN + I_IN + I_OUT;
    auto decode = [&](int it) -> TrDesc {
        const int l = it / PER_LAYER; int r = it % PER_LAYER;
        unsigned char* wl = A.ws + WS_W + (size_t)l * W_LAYER;
        if (r < I_GU) return tr_desc(A.g1 + (size_t)l * D * FF, D, FF, (bf16*)(wl + WO_GU1), A.n1 + l * D, 1, r, FF / 32); r -= I_GU;
        if (r < I_GU) return tr_desc(A.u1 + (size_t)l * D * FF, D, FF, (bf16*)(wl + WO_GU1), A.n1 + l * D, 2, r, FF / 32); r -= I_GU;
        if (r < I_DN) return tr_desc(A.d1 + (size_t)l * D * FF, FF, D, (bf16*)(wl + WO_D1), nullptr, 0, r, D / 32); r -= I_DN;
        if (r < I_IN) return tr_desc(A.win + (size_t)l * D * DIN, D, DIN, (bf16*)(wl + WO_IN), A.nm + l * D, 0, r, NP / 32); r -= I_IN;
        if (r < I_OUT) return tr_desc(A.wout + (size_t)l * D * D, D, D, (bf16*)(wl + WO_OUT), nullptr, 0, r, D / 32); r -= I_OUT;
        if (r < I_GU) return tr_desc(A.g2 + (size_t)l * D * FF, D, FF, (bf16*)(wl + WO_GU2), A.n2 + l * D, 1, r, FF / 32); r -= I_GU;
        if (r < I_GU) return tr_desc(A.u2 + (size_t)l * D * FF, D, FF, (bf16*)(wl + WO_GU2), A.n2 + l * D, 2, r, FF / 32); r -= I_GU;
        return tr_desc(A.d2 + (size_t)l * D * FF, FF, D, (bf16*)(wl + WO_D2), nullptr, 0, r, D / 32); };
    { constexpr int TOTAL = DEPTH * PER_LAYER;
      TrDesc dc; float wc[32]; f32x4 gc[2];
      int it = gw;
      if (it < TOTAL) { dc = decode(it); tr_load(dc, I.lane, wc, gc); }
#pragma unroll 1
      while (it < TOTAL) { const int itn = it + NGW; TrDesc dn = dc; float wn[32]; f32x4 gn[2];
          if (itn < TOTAL) { dn = decode(itn); tr_load(dn, I.lane, wn, gn); }
          tr_finish(dc, I.lane, wc, gc, scr);
          dc = dn; gc[0] = gn[0]; gc[1] = gn[1];
#pragma unroll
          for (int i = 0; i < 32; ++i) wc[i] = wn[i];
          it = itn; } }
    bf16* XB = (bf16*)(A.ws + WS_XB); float* SS = (float*)(A.ws + WS_SS);
    for (int blk = gw; blk < M / 16; blk += NGW) { const int fr = I.lane & 15, fq = I.lane >> 4; const size_t row = (size_t)blk * 16 + fr; float s = 0.f;
#pragma unroll 16
        for (int ct = 0; ct < 32; ++ct) { const GAS f32x4* xp = (const GAS f32x4*)(A.x + row * D + 32 * ct + 8 * fq); const f32x4 a = xp[0], b = xp[1];
            s += ((a.x * a.x + a.y * a.y) + (a.z * a.z + a.w * a.w)) + ((b.x * b.x + b.y * b.y) + (b.z * b.z + b.w * b.w));
            v4u o; o.x = pk2(a.x, a.y); o.y = pk2(a.z, a.w); o.z = pk2(b.x, b.y); o.w = pk2(b.z, b.w);
            *(GAS v4u*)(XB + ((size_t)blk * 32 + ct) * 512 + fr * 32 + 8 * fq) = o; }
        s = xor32_sum(xor16_sum(s));
        *(GAS f32x4*)(SS + row * 16 + 4 * fq) = (f32x4){fq == 0 ? s : 0.f, 0.f, 0.f, 0.f}; }
}
__device__ __forceinline__ void prep_phase(Frame& F, ArgsCP kp, int l) {
    LOAD_ARGS(A, kp);
    const Ids I = phase_ids();
    const bf16* P = (const bf16*)(A.ws + WS_ACT); const float* PF = (const float*)(A.ws + WS_PF);
    float* KMEAN = (float*)(A.ws + WS_KMEAN); bf16* KC = (bf16*)(A.ws + WS_KC); bf16* VC = (bf16*)(A.ws + WS_VC);
    { LAS float* red = (LAS float*)(F.lds + 65536);
      for (int it = blockIdx.x; it < BATCH * 32; it += F.G) { const int b = it >> 5, n = it & 31, tg = I.tid >> 5, c8 = I.tid & 31;
        float s[8];
#pragma unroll
        for (int e = 0; e < 8; ++e) s[e] = 0.f;
        const bf16* src = P + ((size_t)(b * T + n * 256 + tg * 16)) * NP + C_KB + 8 * c8;
#pragma unroll
        for (int i = 0; i < 16; ++i) { const v4u w = *(const GAS v4u*)(src + (size_t)i * NP); s[0] += __uint_as_float(w.x << 16); s[1] += __uint_as_float(w.x & 0xffff0000u); s[2] += __uint_as_float(w.y << 16); s[3] += __uint_as_float(w.y & 0xffff0000u);
            s[4] += __uint_as_float(w.z << 16); s[5] += __uint_as_float(w.z & 0xffff0000u); s[6] += __uint_as_float(w.w << 16); s[7] += __uint_as_float(w.w & 0xffff0000u); }
        __syncthreads();
#pragma unroll
        for (int e = 0; e < 8; ++e) red[tg * 256 + 8 * c8 + e] = s[e];
        __syncthreads();
        if (I.tid < 256) { float t = 0.f;
#pragma unroll
            for (int g2 = 0; g2 < 16; ++g2) t += red[g2 * 256 + I.tid];
            KMEAN[((size_t)((b * 4 + (I.tid >> 6)) * 32 + n)) * 64 + (I.tid & 63)] = t * (1.0f / 256.0f); } } }
    { const float* Wkv = A.wkv + (size_t)l * 128 * 128; const float* kvg = A.kvn + l * 128;
      LAS float* WL = (LAS float*)F.lds;
      __syncthreads();
      for (int i = I.tid; i < 4096; i += NWAVES * 64) ((LAS f32x4*)WL)[i] = ((const GAS f32x4*)Wkv)[i];
      __syncthreads();
      const int gw = blockIdx.x * NWAVES + I.wave, NGW = F.G * NWAVES;
      const float g0 = kvg[I.lane], g1 = kvg[64 + I.lane];
      for (int grp = gw; grp < M / 4; grp += NGW) { const size_t m0 = (size_t)grp * 4;
        typedef float f32x2k __attribute__((ext_vector_type(2)));
        float n0[4], n1[4]; f32x2k acc[4];
#pragma unroll
        for (int t = 0; t < 4; ++t) { const float c0 = PF[(m0 + t) * 512 + PF_CKV + I.lane], c1 = PF[(m0 + t) * 512 + PF_CKV + 64 + I.lane];
            const float ssq = wave_sum(c0 * c0 + c1 * c1); const float r = 1.0f / sqrtf(ssq * (1.0f / 128.0f) + 1e-6f); n0[t] = c0 * r * g0; n1[t] = c1 * r * g1; acc[t] = (f32x2k){0.f, 0.f}; }
#pragma unroll 4
        for (int k = 0; k < 64; ++k) { const f32x2k w = (f32x2k){WL[k * 128 + I.lane], WL[k * 128 + 64 + I.lane]};
#pragma unroll
            for (int t = 0; t < 4; ++t) { const float av = __builtin_bit_cast(float, __builtin_amdgcn_readlane(__builtin_bit_cast(int, n0[t]), k)); acc[t] += w * av; } }
#pragma unroll 4
        for (int k = 0; k < 64; ++k) { const f32x2k w = (f32x2k){WL[(64 + k) * 128 + I.lane], WL[(64 + k) * 128 + 64 + I.lane]};
#pragma unroll
            for (int t = 0; t < 4; ++t) { const float av = __builtin_bit_cast(float, __builtin_amdgcn_readlane(__builtin_bit_cast(int, n1[t]), k)); acc[t] += w * av; } }
#pragma unroll
        for (int t = 0; t < 4; ++t) { KC[(m0 + t) * 64 + I.lane] = (bf16)f2bf(acc[t].x); VC[(m0 + t) * 64 + I.lane] = (bf16)f2bf(acc[t].y); } }
      __syncthreads(); }
}
__device__ __forceinline__ void unpack8(const v4u w, float (&f)[8]) {
    f[0] = __uint_as_float(w.x << 16); f[1] = __uint_as_float(w.x & 0xffff0000u); f[2] = __uint_as_float(w.y << 16); f[3] = __uint_as_float(w.y & 0xffff0000u);
    f[4] = __uint_as_float(w.z << 16); f[5] = __uint_as_float(w.z & 0xffff0000u); f[6] = __uint_as_float(w.w << 16); f[7] = __uint_as_float(w.w & 0xffff0000u);
}
__device__ __forceinline__ void key_step(const v4u (&q)[8], const bf16* krow, const bf16* vrow, float bias, float& mrun, float& lsum, float (&o)[64]) {
    float dot = 0.f;
#pragma unroll
    for (int c = 0; c < 8; ++c) { const v4u kw = *(const GAS v4u*)(krow + 8 * c); float kf[8], qf[8]; unpack8(kw, kf); unpack8(q[c], qf);
#pragma unroll
        for (int e = 0; e < 8; ++e) dot += qf[e] * kf[e]; }
    const float sc = dot + bias, mn = fmaxf(mrun, sc), al = __builtin_amdgcn_exp2f(mrun - mn), p = __builtin_amdgcn_exp2f(sc - mn);
    lsum = lsum * al + p; mrun = mn;
#pragma unroll
    for (int c = 0; c < 8; ++c) { const v4u vw = *(const GAS v4u*)(vrow + 8 * c); float vf[8]; unpack8(vw, vf);
#pragma unroll
        for (int e = 0; e < 8; ++e) o[8 * c + e] = o[8 * c + e] * al + p * vf[e]; }
}
__device__ __forceinline__ void store_o(bf16* dst, const float (&o)[64], float inv) {
#pragma unroll
    for (int c = 0; c < 8; ++c) { v4u w; w.x = pk2(o[8 * c] * inv, o[8 * c + 1] * inv); w.y = pk2(o[8 * c + 2] * inv, o[8 * c + 3] * inv); w.z = pk2(o[8 * c + 4] * inv, o[8 * c + 5] * inv); w.w = pk2(o[8 * c + 6] * inv, o[8 * c + 7] * inv);
        *(GAS v4u*)(dst + 8 * c) = w; }
}
__device__ __forceinline__ void swa_naive(Frame& F, ArgsCP kp, int l) {
    LOAD_ARGS(A, kp);
    const Ids I = phase_ids();
    const bf16* P = (const bf16*)(A.ws + WS_ACT); bf16* ATT = (bf16*)(A.ws + WS_ATT);
    LAS float* biasA = (LAS float*)(F.lds);
    __syncthreads();
    for (int i = I.tid; i < 8 * 128; i += NWAVES * 64) { const int h = i >> 7, d = i & 127; biasA[i] = A.rbt[t5_bucket(d) * 16 + h] * LOG2E; }
    __syncthreads();
    for (int item = blockIdx.x * (NWAVES * 64) + I.tid; item < M * 8; item += F.G * NWAVES * 64) {
        const int h = item / M, m = item % M, t = m & (T - 1);
        v4u q[8];
#pragma unroll
        for (int c = 0; c < 8; ++c) q[c] = *(const GAS v4u*)(P + (size_t)m * NP + C_QA + h * 64 + 8 * c);
        float mrun = A.sinks[l * 8 + h] * LOG2E, lsum = 1.0f, o[64];
#pragma unroll
        for (int e = 0; e < 64; ++e) o[e] = 0.f;
        const int nk = (t + 1 < 128) ? (t + 1) : 128;
        for (int i = 0; i < nk; ++i) { const bf16* row = P + (size_t)(m - i) * NP + (h >> 2) * 64; key_step(q, row + C_KA, row + C_VA, biasA[h * 128 + i], mrun, lsum, o); }
        store_o(ATT + (size_t)m * D + h * 64, o, 1.0f / lsum);
    }
}
__device__ __forceinline__ void moba_naive(Frame& F, ArgsCP kp) {
    LOAD_ARGS(A, kp);
    const Ids I = phase_ids();
    const bf16* P = (const bf16*)(A.ws + WS_ACT); bf16* ATT = (bf16*)(A.ws + WS_ATT); const float* KMEAN = (const float*)(A.ws + WS_KMEAN);
    LAS float* biasB = (LAS float*)(F.lds);
    __syncthreads();
    for (int i = I.tid; i < 4 * 128; i += NWAVES * 64) { const int h = i >> 7, d = i & 127; biasB[i] = A.rbt[t5_bucket(d) * 16 + 8 + h] * LOG2E; }
    __syncthreads();
    for (int item = blockIdx.x * (NWAVES * 64) + I.tid; item < M * 4; item += F.G * NWAVES * 64) {
        const int h = item / M, m = item % M, b = m >> 13, t = m & (T - 1), own = t >> 8;
        v4u q[8];
#pragma unroll
        for (int c = 0; c < 8; ++c) q[c] = *(const GAS v4u*)(P + (size_t)m * NP + C_QB + h * 64 + 8 * c);
        float v0 = -INFINITY, v1 = -INFINITY, v2 = -INFINITY; int i0 = -1, i1 = -1, i2 = -1;
        for (int n = 0; n < own; ++n) { const float* km = KMEAN + ((size_t)((b * 4 + h) * 32 + n)) * 64; float g = 0.f;
#pragma unroll
            for (int c = 0; c < 8; ++c) { float qf[8]; unpack8(q[c], qf); const f32x4 ka = *(const GAS f32x4*)(km + 8 * c), kb = *(const GAS f32x4*)(km + 8 * c + 4);
                g += qf[0] * ka.x + qf[1] * ka.y + qf[2] * ka.z + qf[3] * ka.w + qf[4] * kb.x + qf[5] * kb.y + qf[6] * kb.z + qf[7] * kb.w; }
            if (g > v0) { v2 = v1; i2 = i1; v1 = v0; i1 = i0; v0 = g; i0 = n; } else if (g > v1) { v2 = v1; i2 = i1; v1 = g; i1 = n; } else if (g > v2) { v2 = g; i2 = n; } }
        float mrun = -1e30f, lsum = 0.f, o[64];
#pragma unroll
        for (int e = 0; e < 64; ++e) o[e] = 0.f;
        const size_t rb = (size_t)b * T;
        for (int s = own * 256; s <= t; ++s) { const bf16* row = P + (rb + s) * NP + h * 64; const int dd = t - s; key_step(q, row + C_KB, row + C_VB, biasB[h * 128 + (dd < 127 ? dd : 127)], mrun, lsum, o); }
        for (int j = 0; j < 3; ++j) { const int blk = (j == 0) ? i0 : (j == 1) ? i1 : i2; if (blk < 0) continue;
            for (int s = blk * 256; s < blk * 256 + 256; ++s) { const bf16* row = P + (rb + s) * NP + h * 64; const int dd = t - s; key_step(q, row + C_KB, row + C_VB, biasB[h * 128 + (dd < 127 ? dd : 127)], mrun, lsum, o); } }
        store_o(ATT + (size_t)m * D + 512 + h * 64, o, 1.0f / lsum);
    }
}
__device__ __forceinline__ unsigned fkey(float f) { unsigned u = __float_as_uint(f); if (u == 0x80000000u) u = 0u; return (u & 0x80000000u) ? ~u : (u | 0x80000000u); }
__device__ __forceinline__ void dsa_naive(Frame& F, ArgsCP kp) {
    LOAD_ARGS(A, kp);
    const Ids I = phase_ids();
    const bf16* P = (const bf16*)(A.ws + WS_ACT); const float* PF = (const float*)(A.ws + WS_PF); bf16* ATT = (bf16*)(A.ws + WS_ATT);
    const bf16* KC = (const bf16*)(A.ws + WS_KC); const bf16* VC = (const bf16*)(A.ws + WS_VC);
    LAS unsigned* KEYS = (LAS unsigned*)(F.lds);
    LAS float* QI = (LAS float*)(F.lds + 32768);
    LAS float* QC = (LAS float*)(F.lds + 33792);
    LAS float* PB = (LAS float*)(F.lds + 34816);
    LAS unsigned* LIST = (LAS unsigned*)(F.lds + 38912);
    LAS unsigned* HIST = (LAS unsigned*)(F.lds + 39936);
    LAS float* biasC = (LAS float*)(F.lds + 40960);
    LAS float* RED = (LAS float*)(F.lds + 43008);
    LAS unsigned* MS = (LAS unsigned*)(F.lds + 43264);
    LAS float* WQ = (LAS float*)(F.lds + 43328);
    const int tid = I.tid, lane = I.lane, wave = I.wave;
    __syncthreads();
    for (int i = tid; i < 4 * 128; i += NWAVES * 64) { const int h = i >> 7, d = i & 127; biasC[i] = A.rbt[t5_bucket(d) * 16 + 12 + h] * LOG2E; }
    for (int m = blockIdx.x; m < M; m += F.G) {
        const int b = m >> 13, t = m & (T - 1), nk = t + 1; const size_t rb = (size_t)b * T;
        __syncthreads();
        if (tid < 256) QI[tid] = PF[(size_t)m * 512 + PF_QIDX + tid] * 0.125f; else QC[tid - 256] = bf2f(P[(size_t)m * NP + C_QC + (tid - 256)]);
        if (tid < 4) WQ[tid] = PF[(size_t)m * 512 + PF_WIDX + tid] * 0.5f;
        __syncthreads();
        const float w0 = WQ[0], w1 = WQ[1], w2 = WQ[2], w3 = WQ[3];
        for (int s = tid; s < nk; s += NWAVES * 64) {
            const GAS f32x4* kr = (const GAS f32x4*)(PF + (rb + s) * 512 + PF_KIDX); const LAS f32x4* q4 = (const LAS f32x4*)QI;
            float d0 = 0.f, d1 = 0.f, d2 = 0.f, d3 = 0.f;
#pragma unroll 4
            for (int c = 0; c < 16; ++c) { const f32x4 k = kr[c]; const f32x4 a0 = q4[c], a1 = q4[16 + c], a2 = q4[32 + c], a3 = q4[48 + c];
                d0 += k.x * a0.x + k.y * a0.y + k.z * a0.z + k.w * a0.w; d1 += k.x * a1.x + k.y * a1.y + k.z * a1.z + k.w * a1.w;
                d2 += k.x * a2.x + k.y * a2.y + k.z * a2.z + k.w * a2.w; d3 += k.x * a3.x + k.y * a3.y + k.z * a3.z + k.w * a3.w; }
            float sc = fmaxf(d0, 0.f) * w0; sc += fmaxf(d1, 0.f) * w1; sc += fmaxf(d2, 0.f) * w2; sc += fmaxf(d3, 0.f) * w3;
            KEYS[s] = fkey(sc);
        }
        int nsel;
        if (nk <= 256) { if (tid < nk) LIST[tid] = (unsigned)tid; nsel = nk; __syncthreads(); }
        else {
            unsigned prefix = 0u, remaining = 256u;
            for (int pass = 3; pass >= 0; --pass) {
                __syncthreads();
                if (tid < 256) HIST[tid] = 0u;
                __syncthreads();
                const int shift = 8 * pass;
                for (int s = tid; s < nk; s += NWAVES * 64) { const unsigned key = KEYS[s]; const bool match = (pass == 3) || ((key >> (shift + 8)) == prefix);
                    if (match) __hip_atomic_fetch_add(&HIST[(key >> shift) & 255u], 1u, __ATOMIC_RELAXED, __HIP_MEMORY_SCOPE_WORKGROUP); }
                __syncthreads();
                if (wave == 0) {
                    const unsigned c0 = HIST[255 - 4 * lane], c1 = HIST[254 - 4 * lane], c2 = HIST[253 - 4 * lane], c3 = HIST[252 - 4 * lane], tot = c0 + c1 + c2 + c3;
                    unsigned incl = wave_scan_incl(tot);
                    const unsigned excl = incl - tot;
                    if (excl < remaining && remaining <= incl) { unsigned r = remaining - excl, digit;
                        if (r <= c0) digit = 255 - 4 * lane; else { r -= c0; if (r <= c1) digit = 254 - 4 * lane; else { r -= c1; if (r <= c2) digit = 253 - 4 * lane; else { r -= c2; digit = 252 - 4 * lane; } } }
                        MS[0] = (prefix << 8) | digit; MS[1] = r; }
                }
                __syncthreads();
                prefix = MS[0]; remaining = MS[1];
            }
            if (tid == 0) MS[2] = 0u;
            __syncthreads();
            const unsigned tk = prefix, r = remaining, ngt = 256u - r;
            for (int s = tid; s < nk; s += NWAVES * 64) if (KEYS[s] > tk) { const unsigned slot = __hip_atomic_fetch_add(&MS[2], 1u, __ATOMIC_RELAXED, __HIP_MEMORY_SCOPE_WORKGROUP); if (slot < 256u) LIST[slot] = (unsigned)s; }
            if (wave == 0) { unsigned base = 0u;
                for (int s0 = 0; s0 < nk && base < r; s0 += 64) { const int s = s0 + lane; const bool eq = (s < nk) && (KEYS[s] == tk); const unsigned long long mask = __ballot(eq);
                    const unsigned pos = base + (unsigned)__popcll(mask & ((1ull << lane) - 1ull)); if (eq && pos < r) LIST[ngt + pos] = (unsigned)s; base += (unsigned)__popcll(mask); } }
            nsel = 256; __syncthreads();
        }
        { const int h = tid >> 7, j = tid & 127; float sc2[2];
#pragma unroll
            for (int u = 0; u < 2; ++u) { const int jj = j + 128 * u; float sc = -INFINITY;
                if (jj < nsel) { const int s = (int)LIST[jj]; const bf16* krow = KC + (rb + s) * 64; float dot = 0.f;
#pragma unroll
                    for (int c = 0; c < 8; ++c) { const v4u kw = *(const GAS v4u*)(krow + 8 * c); float kf[8]; unpack8(kw, kf); const LAS f32x4* q4 = (const LAS f32x4*)(QC + h * 64 + 8 * c); const f32x4 qa = q4[0], qb = q4[1];
                        dot += kf[0] * qa.x + kf[1] * qa.y + kf[2] * qa.z + kf[3] * qa.w + kf[4] * qb.x + kf[5] * qb.y + kf[6] * qb.z + kf[7] * qb.w; }
                    const int dd = t - s; sc = dot + biasC[h * 128 + (dd < 127 ? dd : 127)]; }
                sc2[u] = sc; }
            const float wm = wave_max(fmaxf(sc2[0], sc2[1])); if (lane == 0) RED[wave] = wm;
            __syncthreads();
            const float hm = fmaxf(RED[2 * h], RED[2 * h + 1]);
            const float p0 = __builtin_amdgcn_exp2f(sc2[0] - hm), p1 = __builtin_amdgcn_exp2f(sc2[1] - hm);
            PB[h * 256 + j] = p0; PB[h * 256 + j + 128] = p1;
            const float ws_ = wave_sum(p0 + p1); if (lane == 0) RED[8 + wave] = ws_;
            __syncthreads();
        }
        if (tid < 256) { const int h = tid >> 6, d = tid & 63; float acc = 0.f;
            for (int jj = 0; jj < nsel; ++jj) acc += PB[h * 256 + jj] * bf2f(VC[(rb + LIST[jj]) * 64 + d]);
            const float lsum = RED[8 + 2 * h] + RED[8 + 2 * h + 1];
            ATT[(size_t)m * D + 768 + h * 64 + d] = (bf16)f2bf(acc / lsum); }
    }
    __syncthreads();
}
__device__ __forceinline__ void final_phase(Frame& F, ArgsCP kp) {
    LOAD_ARGS(A, kp);
    const Ids I = phase_ids();
    const float* SS = (const float*)(A.ws + WS_SS); const bf16* XB = (const bf16*)(A.ws + WS_XB);
    const int gw = blockIdx.x * NWAVES + I.wave, NGW = F.G * NWAVES, fr = I.lane & 15, fq = I.lane >> 4;
    for (int blk = gw; blk < M / 16; blk += NGW) { const size_t row = (size_t)blk * 16 + fr;
        const f32x4 sv = *(const GAS f32x4*)(SS + row * 16 + 4 * fq); float s = (sv.x + sv.y) + (sv.z + sv.w); s = xor32_sum(xor16_sum(s));
        const float r = 1.0f / sqrtf(s * (1.0f / 1024.0f) + 1e-6f);
#pragma unroll 8
        for (int ct = 0; ct < 32; ++ct) { const v4u w = *(const GAS v4u*)(XB + ((size_t)blk * 32 + ct) * 512 + fr * 32 + 8 * fq); float x8[8]; unpack8(w, x8);
            const GAS f32x4* gp = (const GAS f32x4*)(A.nf + 32 * ct + 8 * fq); const f32x4 g0 = gp[0], g1 = gp[1];
            GAS f32x4* op = (GAS f32x4*)(A.out + row * D + 32 * ct + 8 * fq);
            op[0] = (f32x4){x8[0] * r * g0.x, x8[1] * r * g0.y, x8[2] * r * g0.z, x8[3] * r * g0.w}; op[1] = (f32x4){x8[4] * r * g1.x, x8[5] * r * g1.y, x8[6] * r * g1.z, x8[7] * r * g1.w}; }
    }
}
#ifndef DSA_CAND_CAP
#define DSA_CAND_CAP 384u
#endif
__device__ __forceinline__ int xcd_vblock(int G) { const int bx = blockIdx.x; return (G % 8 == 0) ? (bx % 8) * (G / 8) + bx / 8 : bx; }
typedef float f32x16 __attribute__((ext_vector_type(16)));
typedef short s16x4 __attribute__((ext_vector_type(4)));
typedef short v4i16_t __attribute__((ext_vector_type(4)));
__device__ __forceinline__ int crow(int i, int h) { return (i & 3) + 8 * (i >> 2) + 4 * h; }
typedef float f32x2_t __attribute__((ext_vector_type(2))); typedef __bf16 bf16x2_t __attribute__((ext_vector_type(2)));
__device__ __forceinline__ unsigned cvtpk(float lo, float hi) { const f32x2_t v = {lo, hi}; const bf16x2_t b = __builtin_convertvector(v, bf16x2_t); return __builtin_bit_cast(unsigned, b); }
__device__ __forceinline__ s16x4 vtr(const LAS unsigned char* p) { return __builtin_bit_cast(s16x4, __builtin_amdgcn_ds_read_tr16_b64_v4i16((LAS v4i16_t*)p)); }
__device__ __forceinline__ void glds16(const void* gsrc, unsigned lds_dst) { unsigned keep;
    asm volatile("s_mov_b32 %0, m0\n\ts_mov_b32 m0, %2\n\ts_nop 0\n\tglobal_load_lds_dwordx4 %1, off\n\ts_mov_b32 m0, %0" : "=&s"(keep) : "v"(gsrc), "s"(lds_dst) : "memory"); }
#define ATT_DMA16(gsrc, ldsdst) glds16((const void*)(gsrc), (unsigned)__builtin_amdgcn_readfirstlane((int)(unsigned)(size_t)(ldsdst)))
__device__ __forceinline__ f32x16 qk_tile(const LAS unsigned char* Kimg, int NK, int k0, const bf16x8 (&qf)[4], int r32, int hi, float cinit) {
    f32x16 acc;
#pragma unroll
    for (int i = 0; i < 16; ++i) acc[i] = cinit;
#pragma unroll
    for (int s = 0; s < 4; ++s) { const bf16x8 kf = *(const LAS bf16x8*)(Kimg + ((2 * s + hi) * NK + k0 + r32) * 16); acc = __builtin_amdgcn_mfma_f32_32x32x16_bf16(kf, qf[s], acc, 0, 0, 0); }
    return acc;
}
__device__ __forceinline__ void softmax_pv(f32x16 sc, const LAS unsigned char* Vimg, int NK, int k0, int lane, float& m, float& l, f32x16& o0, f32x16& o1) {
    float mx = sc[0];
#pragma unroll
    for (int i = 1; i < 16; ++i) mx = fmaxf(mx, sc[i]);
    mx = xor32_max(mx);
    const float mn = fmaxf(m, mx);
    if (__any(mn > m)) { const float al = __builtin_amdgcn_exp2f(m - mn); l *= al; o0 = o0 * al; o1 = o1 * al; m = mn; }
    float rs = 0.f;
#pragma unroll
    for (int i = 0; i < 16; ++i) { sc[i] = __builtin_amdgcn_exp2f(sc[i] - mn); rs += sc[i]; }
    l += rs;
    bf16x8 pf[2];
#pragma unroll
    for (int s = 0; s < 2; ++s) { v4u w; w.x = cvtpk(sc[8 * s], sc[8 * s + 1]); w.y = cvtpk(sc[8 * s + 2], sc[8 * s + 3]); w.z = cvtpk(sc[8 * s + 4], sc[8 * s + 5]); w.w = cvtpk(sc[8 * s + 6], sc[8 * s + 7]); pf[s] = __builtin_bit_cast(bf16x8, w); }
    const int hi = lane >> 5;
    const LAS unsigned char* vb = Vimg + (k0 >> 3) * 512 + (4 * hi + ((lane & 15) >> 2)) * 64 + (16 * ((lane >> 4) & 1) + 4 * (lane & 3)) * 2;
#pragma unroll
    for (int dh = 0; dh < 2; ++dh)
#pragma unroll
        for (int s = 0; s < 2; ++s) { const s16x4 a = vtr(vb + (dh * (NK >> 3) + 2 * s) * 512), b = vtr(vb + (dh * (NK >> 3) + 2 * s + 1) * 512);
            const bf16x8 vf = (bf16x8){a[0], a[1], a[2], a[3], b[0], b[1], b[2], b[3]};
            if (dh == 0) o0 = __builtin_amdgcn_mfma_f32_32x32x16_bf16(vf, pf[s], o0, 0, 0, 0); else o1 = __builtin_amdgcn_mfma_f32_32x32x16_bf16(vf, pf[s], o1, 0, 0, 0); }
}
__device__ __forceinline__ void store_ot(bf16* dst, const f32x16& o0, const f32x16& o1, float inv, int hi) {
    typedef unsigned u32x2v __attribute__((ext_vector_type(2)));
#pragma unroll
    for (int g = 0; g < 4; ++g) { u32x2v w; w.x = cvtpk(o0[4 * g] * inv, o0[4 * g + 1] * inv); w.y = cvtpk(o0[4 * g + 2] * inv, o0[4 * g + 3] * inv); *(GAS u32x2v*)(dst + 8 * g + 4 * hi) = w;
        u32x2v x; x.x = cvtpk(o1[4 * g] * inv, o1[4 * g + 1] * inv); x.y = cvtpk(o1[4 * g + 2] * inv, o1[4 * g + 3] * inv); *(GAS u32x2v*)(dst + 32 + 8 * g + 4 * hi) = x; }
}
template <int NK> __device__ __forceinline__ void stage_kv(const bf16* Kg, const bf16* Vg, int ld, LAS unsigned char* Kimg, LAS unsigned char* Vimg, int wave, int lane) {
#pragma unroll
    for (int p = wave; p < 8 * (NK / 64); p += NWAVES) { const int c = p & 7, g = p >> 3; ATT_DMA16(Kg + (size_t)(64 * g + lane) * ld + 8 * c, Kimg + (c * NK + 64 * g) * 16); }
#pragma unroll
    for (int p = wave; p < 2 * (NK / 16); p += NWAVES) { const int dh = p & 1, kg = p >> 1; ATT_DMA16(Vg + (size_t)(16 * kg + (lane >> 2)) * ld + 32 * dh + 8 * (lane & 3), Vimg + (dh * (NK / 8) + 2 * kg) * 512); }
}
constexpr int DS_UP_MOBA = 131584;
__device__ __forceinline__ void moba_phase(Frame& F, ArgsCP kp) {
    LOAD_ARGS(A, kp);
    const Ids I = phase_ids(); const int tid = I.tid, lane = I.lane, wave = I.wave, r32 = lane & 31, hi = lane >> 5;
    const bf16* P = (const bf16*)(A.ws + WS_ACT); bf16* ATT = (bf16*)(A.ws + WS_ATT); const float* KMEAN = (const float*)(A.ws + WS_KMEAN);
    constexpr int MOBA_BUF0 = 0;
    LAS float* biasB = (LAS float*)(F.lds + DS_UP_MOBA);
    LAS unsigned* selm = (LAS unsigned*)(F.lds + DS_UP_MOBA + 512);
    for (int w = F.vb; w < 256; w += F.G)
        for (int half = 0; half < 2; ++half) {
            const int bh = w >> 4, ob = half ? 31 - (w & 15) : (w & 15), b = bh >> 2, h = bh & 3;
            const size_t rb = (size_t)b * T;
            __syncthreads();
            if (tid < 128) biasB[tid] = A.rbt[t5_bucket(tid) * 16 + 8 + h] * LOG2E;
            if (tid < 256) {
                const bf16* qp = P + (rb + ob * 256 + tid) * NP + C_QB + h * 64; float qf[64];
#pragma unroll
                for (int c = 0; c < 8; ++c) { const v4u qw = *(const GAS v4u*)(qp + 8 * c); float t8[8]; unpack8(qw, t8);
#pragma unroll
                    for (int e = 0; e < 8; ++e) qf[8 * c + e] = t8[e]; }
                float v0 = -INFINITY, v1 = -INFINITY, v2 = -INFINITY; int i0 = -1, i1 = -1, i2 = -1;
                for (int n = 0; n < ob; ++n) { const float* km = KMEAN + ((size_t)(bh * 32 + n)) * 64; float g = 0.f;
#pragma unroll
                    for (int e = 0; e < 64; ++e) g += qf[e] * km[e];
                    if (g > v0) { v2 = v1; i2 = i1; v1 = v0; i1 = i0; v0 = g; i0 = n; } else if (g > v1) { v2 = v1; i2 = i1; v1 = g; i1 = n; } else if (g > v2) { v2 = g; i2 = n; } }
                unsigned msk = 0u; if (i0 >= 0) msk |= 1u << i0; if (i1 >= 0) msk |= 1u << i1; if (i2 >= 0) msk |= 1u << i2;
                selm[tid] = msk; }
            __syncthreads();
            const int qi = wave * 32 + r32, tq = ob * 256 + qi; const unsigned smask = selm[qi];
            bf16x8 qf[4];
#pragma unroll
            for (int s = 0; s < 4; ++s) qf[s] = *(const GAS bf16x8*)(P + (rb + tq) * NP + C_QB + h * 64 + 16 * s + 8 * hi);
            const float b31 = biasB[127];
            float m = -1e30f, l = 0.f; f32x16 o0, o1;
#pragma unroll
            for (int i = 0; i < 16; ++i) { o0[i] = 0.f; o1[i] = 0.f; }
            stage_kv<256>(P + rb * NP + C_KB + h * 64, P + rb * NP + C_VB + h * 64, NP, F.lds + MOBA_BUF0, F.lds + MOBA_BUF0 + 32768, wave, lane);
            for (int j = 0; j <= ob; ++j) {
                asm volatile("s_waitcnt vmcnt(0)" ::: "memory");
                __syncthreads();
                LAS unsigned char* Kimg = F.lds + MOBA_BUF0 + (j & 1) * 65536; LAS unsigned char* Vimg = Kimg + 32768;
                if (j < ob) { LAS unsigned char* Kn = F.lds + MOBA_BUF0 + ((j + 1) & 1) * 65536;
                    stage_kv<256>(P + (rb + (j + 1) * 256) * NP + C_KB + h * 64, P + (rb + (j + 1) * 256) * NP + C_VB + h * 64, NP, Kn, Kn + 32768, wave, lane); }
                const bool own = (j == ob), sel = own || ((smask >> j) & 1u);
                if (!__any(sel)) continue;
                const int ntile = own ? wave + 1 : 8;
                for (int kt = 0; kt < ntile; ++kt) {
                    const int s0 = j * 256 + kt * 32, dmin = (ob * 256 + wave * 32) - (s0 + 31);
                    const bool cb = dmin >= 113;
                    f32x16 sc = qk_tile(Kimg, 256, kt * 32, qf, r32, hi, cb ? b31 : 0.f);
                    if (!cb) {
#pragma unroll
                        for (int i = 0; i < 16; ++i) { const int dd = tq - (s0 + crow(i, hi)); const int dc = dd < 0 ? 0 : (dd > 127 ? 127 : dd); const float v = sc[i] + biasB[dc]; sc[i] = dd < 0 ? -INFINITY : v; } }
                    if (!sel) {
#pragma unroll
                        for (int i = 0; i < 16; ++i) sc[i] = -INFINITY; }
                    softmax_pv(sc, Vimg, 256, kt * 32, lane, m, l, o0, o1);
                }
            }
            l += __shfl_xor(l, 32);
            store_ot(ATT + (rb + tq) * D + 512 + h * 64, o0, o1, 1.0f / l, hi);
        }
    __syncthreads();
}
#ifndef DSADUP
#define DSADUP 0
#endif
typedef _Float16 f16x8 __attribute__((ext_vector_type(8)));
constexpr int HROW = 1028;
constexpr int DS_UP = 131584, DS_LIST = DS_UP, DS_META = DS_LIST + 16384, DS_BIAS = DS_META + 1024, DS_RAD = DS_BIAS + 2048, DS_DUMP = DS_RAD + 4096, DS_END = DS_DUMP + 4096;
static_assert(DS_END <= LDSCTL_OFF && 32 * HROW * 4 <= DS_UP, "DSA LDS map");
enum { MT_THR = 0, MT_R = 1, MT_MODE = 2, MT_LCNT = 3, MT_CCNT = 4, MT_LO = 5, MT_HI = 6 };
enum { MODE_CAND = 0, MODE_TIE = 1, MODE_OVER = 2 };
__device__ __forceinline__ unsigned fkey32(float f) { const unsigned u = __float_as_uint(f); return u ^ ((unsigned)((int)u >> 31) | 0x80000000u); }
__device__ __forceinline__ float relu_bits(float x) { const int xi = __builtin_bit_cast(int, x); return __builtin_bit_cast(float, xi > 0 ? xi : 0); }
constexpr unsigned HB_MB = 4u, HB_SH = 23u - HB_MB, LOB = (127u - 32u) << HB_MB;
__device__ __forceinline__ void hist_bin(unsigned key, unsigned row_b2, unsigned c65535, unsigned& addr, unsigned& inc) {
    const int c = (int)__builtin_amdgcn_ubfe(key, HB_SH, 8u + HB_MB); const int cc = c < (int)LOB ? (int)LOB : (c > (int)LOB + 1023 ? (int)LOB + 1023 : c);
    unsigned a; asm("v_bfe_u32 %0, %1, 1, 12\n\tv_lshl_add_u32 %0, %0, 2, %2" : "=&v"(a) : "v"(cc), "v"(row_b2));
    addr = a + ((key >> 31) << 11);
    const unsigned b = (unsigned)cc & 1u; asm("v_mad_u32_u24 %0, %1, %2, 1" : "=v"(inc) : "v"(b), "s"(c65535));
}
__device__ __forceinline__ void horner_ge(unsigned& x, float v, float thr) { unsigned long long c; asm("v_cmp_ge_f32 %0, %1, %2" : "=s"(c) : "v"(v), "v"(thr)); asm("v_addc_co_u32 %0, vcc, %0, %0, %1" : "+v"(x) : "s"(c) : "vcc"); }
__device__ __forceinline__ f32x16 idx_score_tile(const f16x8 (&kf)[4], const LAS unsigned char* qimg, const float (&w)[4], int r32, int hi) {
    f32x16 sc;
#pragma unroll
    for (int i = 0; i < 16; ++i) sc[i] = 0.f;
#pragma unroll
    for (int h = 0; h < 4; ++h) { f32x16 acc;
#pragma unroll
        for (int i = 0; i < 16; ++i) acc[i] = 0.f;
#pragma unroll
        for (int s = 0; s < 4; ++s) { const f16x8 qf = *(const LAS f16x8*)(qimg + ((h * 8 + 2 * s + hi) * 32 + r32) * 16); acc = __builtin_amdgcn_mfma_f32_32x32x16_f16(kf[s], qf, acc, 0, 0, 0); }
#pragma unroll
        for (int i = 0; i < 16; ++i) sc[i] = __builtin_fmaf(relu_bits(acc[i]), w[h], sc[i]); }
    return sc;
}
__device__ __forceinline__ unsigned wave_umin(unsigned v) {
#define WUM_STEP(ctrl, rm) { const unsigned x_ = (unsigned)__builtin_amdgcn_update_dpp((int)0xffffffffu, (int)v, ctrl, rm, 0xf, false); v = x_ < v ? x_ : v; }
    WUM_STEP(0x111, 0xf) WUM_STEP(0x112, 0xf) WUM_STEP(0x114, 0xf) WUM_STEP(0x118, 0xf) WUM_STEP(0x142, 0xa) WUM_STEP(0x143, 0xc)
#undef WUM_STEP
    return (unsigned)__builtin_amdgcn_readlane((int)v, 63);
}
__device__ __forceinline__ void mask_to_list(const LAS unsigned* mask, LAS unsigned short* lst, LAS unsigned short* dump, int lane) {
    const v4u x = ((const LAS v4u*)mask)[lane]; const unsigned c0 = __popc(x.x), c1 = __popc(x.y), c2 = __popc(x.z), tot = c0 + c1 + c2 + __popc(x.w);
    unsigned incl = wave_scan_incl(tot);
    const unsigned rank0 = incl - tot;
#pragma unroll
    for (int k = 0; k < 4; ++k) { unsigned wv = k == 0 ? x.x : k == 1 ? x.y : k == 2 ? x.z : x.w; unsigned rank = k == 0 ? rank0 : k == 1 ? rank0 + c0 : k == 2 ? rank0 + c0 + c1 : rank0 + c0 + c1 + c2;
        const unsigned kb = (unsigned)((4 * lane + k) * 32);
#pragma unroll
        for (int st = 0; st < 4; ++st) { const bool on = wv != 0u && rank < 256u; const unsigned bpos = (unsigned)__builtin_ctz(wv | 0x80000000u);
            LAS unsigned short* dst = on ? lst + rank : dump; *dst = (unsigned short)(kb + bpos); rank += (wv != 0u) ? 1u : 0u; wv &= wv - 1u; }
        while (wv != 0u) { const unsigned bpos = (unsigned)__ffs((int)wv) - 1u; if (rank < 256u) lst[rank] = (unsigned short)(kb + bpos); ++rank; wv &= wv - 1u; } }
}
__device__ __forceinline__ void mask_to_list(const LAS unsigned* mask, LAS unsigned short* lst, int lane) {
    const v4u x = ((const LAS v4u*)mask)[lane]; const unsigned tot = __popc(x.x) + __popc(x.y) + __popc(x.z) + __popc(x.w);
    unsigned incl = wave_scan_incl(tot);
    unsigned rank = incl - tot;
#pragma unroll
    for (int k = 0; k < 4; ++k) { unsigned wv = k == 0 ? x.x : k == 1 ? x.y : k == 2 ? x.z : x.w;
        while (wv != 0u) { const unsigned bpos = (unsigned)__ffs((int)wv) - 1u; if (rank < 256u) lst[rank] = (unsigned short)((4 * lane + k) * 32 + bpos); ++rank; wv &= wv - 1u; } }
}
__device__ __forceinline__ void dsa_select_wg(const float* PF, int m, LAS unsigned char* scr, LAS unsigned short* lst, int tid, int lane, int wave) {
    LAS unsigned* KEYS = (LAS unsigned*)scr; LAS float* QI = (LAS float*)(scr + 32768); LAS unsigned* HIST = (LAS unsigned*)(scr + 33792); LAS unsigned* MS = (LAS unsigned*)(scr + 34816); LAS float* WQ = (LAS float*)(scr + 34880);
    const int b = m >> 13, t = m & (T - 1), nk = t + 1; const size_t rb = (size_t)b * T;
    __syncthreads();
    if (tid < 256) QI[tid] = PF[(size_t)m * 512 + PF_QIDX + tid] * 0.125f;
    if (tid < 4) WQ[tid] = PF[(size_t)m * 512 + PF_WIDX + tid] * 0.5f;
    __syncthreads();
    const float w0 = WQ[0], w1 = WQ[1], w2 = WQ[2], w3 = WQ[3];
    for (int s = tid; s < nk; s += NWAVES * 64) {
        const GAS f32x4* kr = (const GAS f32x4*)(PF + (rb + s) * 512 + PF_KIDX); const LAS f32x4* q4 = (const LAS f32x4*)QI;
        float d0 = 0.f, d1 = 0.f, d2 = 0.f, d3 = 0.f;
#pragma unroll 4
        for (int c = 0; c < 16; ++c) { const f32x4 k = kr[c]; const f32x4 a0 = q4[c], a1 = q4[16 + c], a2 = q4[32 + c], a3 = q4[48 + c];
            d0 += k.x * a0.x + k.y * a0.y + k.z * a0.z + k.w * a0.w; d1 += k.x * a1.x + k.y * a1.y + k.z * a1.z + k.w * a1.w;
            d2 += k.x * a2.x + k.y * a2.y + k.z * a2.z + k.w * a2.w; d3 += k.x * a3.x + k.y * a3.y + k.z * a3.z + k.w * a3.w; }
        float sc = fmaxf(d0, 0.f) * w0; sc += fmaxf(d1, 0.f) * w1; sc += fmaxf(d2, 0.f) * w2; sc += fmaxf(d3, 0.f) * w3;
        KEYS[s] = fkey(sc);
    }
    unsigned prefix = 0u, remaining = 256u;
    for (int pass = 3; pass >= 0; --pass) {
        __syncthreads();
        if (tid < 256) HIST[tid] = 0u;
        __syncthreads();
        const int shift = 8 * pass;
        for (int s = tid; s < nk; s += NWAVES * 64) { const unsigned key = KEYS[s]; const bool match = (pass == 3) || ((key >> (shift + 8)) == prefix);
            if (match) __hip_atomic_fetch_add(&HIST[(key >> shift) & 255u], 1u, __ATOMIC_RELAXED, __HIP_MEMORY_SCOPE_WORKGROUP); }
        __syncthreads();
        if (wave == 0) {
            const unsigned c0 = HIST[255 - 4 * lane], c1 = HIST[254 - 4 * lane], c2 = HIST[253 - 4 * lane], c3 = HIST[252 - 4 * lane], tot = c0 + c1 + c2 + c3;
            unsigned incl = wave_scan_incl(tot);
            const unsigned excl = incl - tot;
            if (excl < remaining && remaining <= incl) { unsigned r = remaining - excl, digit;
                if (r <= c0) digit = 255 - 4 * lane; else { r -= c0; if (r <= c1) digit = 254 - 4 * lane; else { r -= c1; if (r <= c2) digit = 253 - 4 * lane; else { r -= c2; digit = 252 - 4 * lane; } } }
                MS[0] = (prefix << 8) | digit; MS[1] = r; }
        }
        __syncthreads();
        prefix = MS[0]; remaining = MS[1];
    }
    LAS unsigned* SELM = (LAS unsigned*)(scr + 36864);
    if (tid < 256) SELM[tid] = 0u;
    __syncthreads();
    const unsigned tk = prefix, r = remaining;
    for (int s = tid; s < nk; s += NWAVES * 64) if (KEYS[s] > tk) __hip_atomic_fetch_or(&SELM[s >> 5], 1u << (s & 31), __ATOMIC_RELAXED, __HIP_MEMORY_SCOPE_WORKGROUP);
    if (wave == 0) { unsigned base = 0u;
        for (int s0 = 0; s0 < nk && base < r; s0 += 64) { const int s = s0 + lane; const bool eq = (s < nk) && (KEYS[s] == tk); const unsigned long long mask = __ballot(eq);
            const unsigned pos = base + (unsigned)__popcll(mask & ((1ull << lane) - 1ull)); if (eq && pos < r) __hip_atomic_fetch_or(&SELM[s >> 5], 1u << (s & 31), __ATOMIC_RELAXED, __HIP_MEMORY_SCOPE_WORKGROUP); base += (unsigned)__popcll(mask); } }
    __syncthreads();
    if (wave == 0) mask_to_list(SELM, lst, lane);
    __syncthreads();
}
__device__ __forceinline__ void dsa_phase(Frame& F, ArgsCP kp) {
    LOAD_ARGS(A, kp);
    const Ids I = phase_ids(); const int tid = I.tid, lane = I.lane, wave = I.wave, r32 = lane & 31, hi = lane >> 5;
    const bf16* P = (const bf16*)(A.ws + WS_ACT); const float* PF = (const float*)(A.ws + WS_PF); bf16* ATT = (bf16*)(A.ws + WS_ATT);
    const bf16* KC = (const bf16*)(A.ws + WS_KC); const bf16* VC = (const bf16*)(A.ws + WS_VC);
    const _Float16* QIH = (const _Float16*)(A.ws + WS_QIH); const _Float16* KIH = (const _Float16*)(A.ws + WS_KIH); unsigned short* LISTG = (unsigned short*)(A.ws + WS_LISTG);
    LAS unsigned* HISTW = (LAS unsigned*)F.lds;
    LAS unsigned short* LIST = (LAS unsigned short*)(F.lds + DS_LIST);
    LAS unsigned* META = (LAS unsigned*)(F.lds + DS_META);
    LAS float* biasC = (LAS float*)(F.lds + DS_BIAS);
    LAS unsigned* RAD = (LAS unsigned*)(F.lds + DS_RAD) + wave * 128;
    unsigned zu_ = 0u; asm volatile("" : "+v"(zu_));
    __syncthreads();
    for (int i = tid; i < 4 * 128; i += NWAVES * 64) { const int h = i >> 7, d = i & 127; biasC[i] = A.rbt[t5_bucket(d) * 16 + 12 + h] * LOG2E; }
    for (int w = F.vb; w < 256; w += F.G)
        for (int part = 0; part < 4; ++part) {
            const int b = w >> 6, j = w & 63, qt = (part == 0) ? j : (part == 1) ? 127 - j : (part == 2) ? 128 + j : 255 - j, t0 = qt * 32;
            const size_t rb = (size_t)b * T;
            __syncthreads();
            if (qt >= 8) {
                for (int i = tid; i < 8 * HROW; i += NWAVES * 64) ((LAS v4u*)HISTW)[i] = (v4u){zu_, zu_, zu_, zu_};
                if (tid < 256) META[tid] = 0u;
                const size_t mq = rb + t0 + r32;
                float wq[4];
#pragma unroll
                for (int h = 0; h < 4; ++h) wq[h] = PF[mq * 512 + PF_WIDX + h] * 0.5f;
                const LAS unsigned char* qimg = F.lds + DS_LIST;
#pragma unroll
                for (int pp = 0; pp < 2; ++pp) { const int p = tid + 512 * pp, q = p & 31, c = (p >> 5) & 7, h = p >> 8;
                    *(LAS f16x8*)(F.lds + DS_LIST + p * 16) = *(const GAS f16x8*)(QIH + (rb + t0 + q) * 256 + h * 64 + 8 * c); }
                __syncthreads();
                for (int rep1 = 0; rep1 <= ((DSADUP >> 0) & 1); ++rep1) {
                if (rep1) { __syncthreads(); for (int i = tid; i < 8 * HROW; i += NWAVES * 64) ((LAS v4u*)HISTW)[i] = (v4u){zu_, zu_, zu_, zu_}; __syncthreads(); }
                const unsigned hrow_b = (unsigned)(size_t)(HISTW + r32 * HROW) - 4u * (LOB >> 1); unsigned c65535 = 65535u; asm volatile("" : "+s"(c65535));
                f16x8 kn[4];
#pragma unroll
                for (int s = 0; s < 4; ++s) kn[s] = *(const GAS f16x8*)(KIH + ((((rb >> 5) + (size_t)(wave <= qt ? wave : qt)) * 8 + 2 * s + hi) * 32 + r32) * 8);
                for (int kt = wave; kt <= qt; kt += NWAVES) {
                    f16x8 kf[4];
#pragma unroll
                    for (int s = 0; s < 4; ++s) kf[s] = kn[s];
                    { const int ktn = kt + NWAVES <= qt ? kt + NWAVES : qt;
#pragma unroll
                      for (int s = 0; s < 4; ++s) kn[s] = *(const GAS f16x8*)(KIH + ((((rb >> 5) + (size_t)ktn) * 8 + 2 * s + hi) * 32 + r32) * 8); }
#ifdef DSA_XSCORE
                    { const f32x16 sc2 = idx_score_tile(kf, qimg, wq, r32, hi);
#pragma unroll
                      for (int i = 0; i < 16; ++i) asm volatile("" :: "v"(sc2[i]));
#pragma unroll
                      for (int s = 0; s < 4; ++s) asm volatile("" : "+v"(kf[s])); }
#endif
#ifdef DSA_XMFMA
                    {
#pragma unroll
                      for (int h = 0; h < 4; ++h) { f32x16 acc2;
#pragma unroll
                          for (int i = 0; i < 16; ++i) acc2[i] = 0.f;
#pragma unroll
                          for (int s = 0; s < 4; ++s) { const f16x8 qf2 = *(const LAS f16x8*)(qimg + ((h * 8 + 2 * s + hi) * 32 + r32) * 16);
#if DSA_XMFMA == 2
                              acc2 = __builtin_amdgcn_mfma_f32_32x32x16_bf16(__builtin_bit_cast(bf16x8, kf[s]), __builtin_bit_cast(bf16x8, qf2), acc2, 0, 0, 0); }
#else
                              acc2 = __builtin_amdgcn_mfma_f32_32x32x16_f16(kf[s], qf2, acc2, 0, 0, 0); }
#endif

                          asm volatile("" :: "v"(acc2)); }
#pragma unroll
                      for (int s = 0; s < 4; ++s) asm volatile("" : "+v"(kf[s])); }
#endif
                    const f32x16 sc = idx_score_tile(kf, qimg, wq, r32, hi);
                    if (kt != qt) {
#pragma unroll
                        for (int i = 0; i < 16; ++i) { const unsigned key = __float_as_uint(sc[i]);
                            unsigned ha, hv; hist_bin(key, hrow_b, c65535, ha, hv); __hip_atomic_fetch_add((LAS unsigned*)(size_t)ha, hv, __ATOMIC_RELAXED, __HIP_MEMORY_SCOPE_WORKGROUP);
                        }
                    } else {
                        int hl = hi; asm volatile("" : "+v"(hl));
#pragma unroll
                        for (int i = 0; i < 16; ++i) { const unsigned key = __float_as_uint(sc[i]);
                            unsigned ha, hv; hist_bin(key, hrow_b, c65535, ha, hv); if (crow(i, hl) <= r32) __hip_atomic_fetch_add((LAS unsigned*)(size_t)ha, hv, __ATOMIC_RELAXED, __HIP_MEMORY_SCOPE_WORKGROUP); }
                    }
                }
                }
                __syncthreads();
#pragma unroll
                for (int qq = 0; qq < 4; ++qq) { const int q = 4 * wave + qq;
                    const int wbase = lane < 32 ? 496 - 16 * lane : 512 + 16 * (lane - 32);
                    const LAS v4u* hw = (const LAS v4u*)(HISTW + q * HROW + wbase);
                    v4u x[4]; unsigned tot = 0u;
#pragma unroll
                    for (int k = 0; k < 4; ++k) { x[k] = hw[k]; tot += (x[k].x & 0xffffu) + (x[k].x >> 16) + (x[k].y & 0xffffu) + (x[k].y >> 16) + (x[k].z & 0xffffu) + (x[k].z >> 16) + (x[k].w & 0xffffu) + (x[k].w >> 16); }
                    unsigned incl = wave_scan_incl(tot);
                    const unsigned excl = incl - tot;
                    if (excl < 256u && 256u <= incl) { unsigned rem = 256u - excl, rb = 0u, cin = 0u; bool found = false;
                        if (lane < 32) {
#pragma unroll
                            for (int k = 15; k >= 0; --k) { const unsigned wv = (k & 3) == 0 ? x[k >> 2].x : (k & 3) == 1 ? x[k >> 2].y : (k & 3) == 2 ? x[k >> 2].z : x[k >> 2].w;
                                unsigned c = wv >> 16; if (!found) { if (rem <= c) { found = true; rb = 2u * (unsigned)(wbase + k) + 1u; cin = c; } else rem -= c; }
                                c = wv & 0xffffu; if (!found) { if (rem <= c) { found = true; rb = 2u * (unsigned)(wbase + k); cin = c; } else rem -= c; } }
                        } else {
#pragma unroll
                            for (int k = 0; k < 16; ++k) { const unsigned wv = (k & 3) == 0 ? x[k >> 2].x : (k & 3) == 1 ? x[k >> 2].y : (k & 3) == 2 ? x[k >> 2].z : x[k >> 2].w;
                                unsigned c = wv & 0xffffu; if (!found) { if (rem <= c) { found = true; rb = 2u * (unsigned)(wbase + k); cin = c; } else rem -= c; }
                                c = wv >> 16; if (!found) { if (rem <= c) { found = true; rb = 2u * (unsigned)(wbase + k) + 1u; cin = c; } else rem -= c; } }
                        }
                        const unsigned c = rb & 1023u; const bool neg = rb >= 1024u, wide = (c == 1023u) || (neg && c == 0u);
                        unsigned blo, bhi;
                        if (!neg) { blo = c == 0u ? 0u : (c + LOB) << HB_SH; bhi = c == 1023u ? 0x7f800000u : (c + 1u + LOB) << HB_SH; }
                        else { blo = 0x80000000u | (c == 1023u ? 0x7f7fffffu : ((c + 1u + LOB) << HB_SH) - 1u); bhi = c == 0u ? 1u : (0x80000000u | (((c + LOB) << HB_SH) - 1u)); }
                        const bool over = (rb != 0u) && (cin > DSA_CAND_CAP || wide);
                        META[MT_THR * 32 + q] = fkey32(__uint_as_float(blo));
                        META[MT_R * 32 + q] = rem; META[MT_MODE * 32 + q] = (rb == 0u) ? MODE_TIE : (over ? MODE_OVER : MODE_CAND); if (over) META[MT_LCNT * 32] = 1u;
                        META[MT_LO * 32 + q] = blo; META[MT_HI * 32 + q] = bhi; }
                }
                __syncthreads();
#pragma unroll 1
                for (int qq = 0; qq < 4; ++qq) { const int q = 4 * wave + qq; ((LAS v4u*)(HISTW + q * HROW + 768))[lane] = (v4u){zu_, zu_, zu_, zu_}; if (META[MT_MODE * 32 + q] == MODE_TIE) ((LAS v4u*)(HISTW + q * HROW))[lane] = (v4u){zu_, zu_, zu_, zu_}; }
                __syncthreads();
                for (int rep2 = 0; rep2 <= ((DSADUP >> 1) & 1); ++rep2) {
                if (rep2) { __syncthreads(); for (int qq = 0; qq < 4; ++qq) { const int q = 4 * wave + qq; ((LAS v4u*)(HISTW + q * HROW + 768))[lane] = (v4u){zu_, zu_, zu_, zu_}; if (META[MT_MODE * 32 + q] == MODE_TIE) ((LAS v4u*)(HISTW + q * HROW))[lane] = (v4u){zu_, zu_, zu_, zu_}; if (lane == 0) META[MT_CCNT * 32 + q] = 0u; } __syncthreads(); }
                { const unsigned mode = META[MT_MODE * 32 + r32]; const float flo = __uint_as_float(META[MT_LO * 32 + r32]), fhi = __uint_as_float(META[MT_HI * 32 + r32]);
                  f16x8 kn[4];
#pragma unroll
                  for (int s = 0; s < 4; ++s) kn[s] = *(const GAS f16x8*)(KIH + ((((rb >> 5) + (size_t)(wave <= qt ? wave : qt)) * 8 + 2 * s + hi) * 32 + r32) * 8);
                  for (int kt = wave; kt <= qt; kt += NWAVES) {
                    f16x8 kf[4];
#pragma unroll
                    for (int s = 0; s < 4; ++s) kf[s] = kn[s];
                    { const int ktn = kt + NWAVES <= qt ? kt + NWAVES : qt;
#pragma unroll
                      for (int s = 0; s < 4; ++s) kn[s] = *(const GAS f16x8*)(KIH + ((((rb >> 5) + (size_t)ktn) * 8 + 2 * s + hi) * 32 + r32) * 8); }
                    const f32x16 sc = idx_score_tile(kf, qimg, wq, r32, hi);
                    const bool diag = (kt == qt);
                    int hl = hi; asm volatile("" : "+v"(hl));
                    unsigned selw = 0u, gew = 0u;
#pragma unroll
                    for (int g = 3; g >= 0; --g) { unsigned ns = 0u, ng = 0u;
#pragma unroll
                        for (int j = 3; j >= 0; --j) { ns = ns + ns + ((sc[4 * g + j] >= fhi) ? 1u : 0u); ng = ng + ng + ((sc[4 * g + j] >= flo) ? 1u : 0u); }
                        selw = (selw << 8) | ns; gew = (gew << 8) | ng; }
                    if (diag) { const int lim = r32 - 4 * hl;
                        const unsigned vm = lim >= 0 ? (0x0F0F0F0Fu & ((2u << lim) - 1u)) : 0u;
                        selw &= vm; gew &= vm; }
                    unsigned eqw = gew & ~selw;
                    selw <<= 4 * hl; { const auto rr_ = __builtin_amdgcn_permlane32_swap(selw, selw, false, false); selw = rr_[0] | rr_[1]; }
                    if (hi == 0) HISTW[r32 * HROW + 768 + kt] = selw;
                    { unsigned tw = eqw << (4 * hl); { const auto rr_ = __builtin_amdgcn_permlane32_swap(tw, tw, false, false); tw = rr_[0] | rr_[1]; } if (mode == MODE_TIE && hi == 0) HISTW[r32 * HROW + kt] = tw; }
                    { unsigned cw = (mode == MODE_CAND) ? eqw : 0u;
                      if (__any(cw != 0u)) {
                        const unsigned pbase = __hip_atomic_fetch_add(&META[MT_CCNT * 32 + r32], (unsigned)__popc(cw), __ATOMIC_RELAXED, __HIP_MEMORY_SCOPE_WORKGROUP);
                        unsigned caddr = (unsigned)(size_t)(HISTW + r32 * HROW) + 8u * pbase; const unsigned kbase = (unsigned)(kt * 32 + 4 * hl);
                        do { const unsigned p = (unsigned)__builtin_ctz(cw | 0x80000000u);
                            const unsigned m0 = 0u - (p & 1u), m1 = 0u - ((p >> 1) & 1u), m2 = 0u - ((p >> 3) & 1u), m3 = 0u - ((p >> 4) & 1u);
                            unsigned a8[8], a4[4], a2[2];
#pragma unroll
                            for (int j = 0; j < 8; ++j) a8[j] = (__float_as_uint(sc[2 * j + 1]) & m0) | (__float_as_uint(sc[2 * j]) & ~m0);
#pragma unroll
                            for (int j = 0; j < 4; ++j) a4[j] = (a8[2 * j + 1] & m1) | (a8[2 * j] & ~m1);
#pragma unroll
                            for (int j = 0; j < 2; ++j) a2[j] = (a4[2 * j + 1] & m2) | (a4[2 * j] & ~m2);
                            const unsigned svb = (a2[1] & m3) | (a2[0] & ~m3);
                            typedef unsigned u32x2w __attribute__((ext_vector_type(2)));
                            if (cw != 0u) { *(LAS u32x2w*)(size_t)caddr = (u32x2w){kbase + p, svb}; caddr += 8u; }
                            cw &= cw - 1u;
                        } while (__any(cw != 0u)); } }
                  } }
                }
                __syncthreads();
                for (int rep3 = 0; rep3 <= ((DSADUP >> 2) & 1); ++rep3)
#pragma unroll 1
                for (int qq = 0; qq < 4; ++qq) { const int q = 4 * wave + qq; const unsigned mode = META[MT_MODE * 32 + q], r = META[MT_R * 32 + q];
                    LAS unsigned* selq = HISTW + q * HROW + 768;
                    if (mode == MODE_TIE) {
                        const v4u x = ((const LAS v4u*)(HISTW + q * HROW))[lane]; const unsigned tot = __popc(x.x) + __popc(x.y) + __popc(x.z) + __popc(x.w);
                        unsigned incl = wave_scan_incl(tot);
                        unsigned rank = incl - tot;
#pragma unroll
                        for (int k = 0; k < 4; ++k) { unsigned wv = k == 0 ? x.x : k == 1 ? x.y : k == 2 ? x.z : x.w, keep = 0u; const unsigned cnt = __popc(wv);
                            if (rank + cnt <= r) keep = wv; else { unsigned n = rank < r ? r - rank : 0u; while (n > 0u && wv != 0u) { const unsigned bb = wv & (0u - wv); keep |= bb; wv ^= bb; --n; } }
                            rank += cnt; if (keep) selq[4 * lane + k] |= keep; }
                    } else if (mode == MODE_CAND) {
                        const unsigned nc = META[MT_CCNT * 32 + q];
                        const LAS unsigned long long* cq = (const LAS unsigned long long*)(HISTW + q * HROW);
#define DSA_CAND_SELECT(NE_) do { \
                        unsigned ck[NE_], ci[NE_]; bool cv[NE_]; const unsigned kbase = META[MT_THR * 32 + q]; \
                        _Pragma("unroll") \
                        for (int e = 0; e < NE_; ++e) { const unsigned id = lane + 64 * e; cv[e] = id < nc; const unsigned long long v = cq[id]; ck[e] = fkey32(__uint_as_float((unsigned)(v >> 32))) - kbase; ci[e] = (unsigned)v & 0xffffu; } \
                        unsigned prefix = 0u, rem = r; \
                        _Pragma("unroll 1") \
                        for (int pass = 0; pass < 3; ++pass) { const int shift = 14 - 7 * pass; \
                            RAD[2 * lane] = 0u; RAD[2 * lane + 1] = 0u; \
                            asm volatile("s_waitcnt lgkmcnt(0)" ::: "memory"); \
                        _Pragma("unroll") \
                            for (int e = 0; e < NE_; ++e) if (cv[e] && (ck[e] >> (shift + 7)) == prefix) __hip_atomic_fetch_add(&RAD[(ck[e] >> shift) & 127u], 1u, __ATOMIC_RELAXED, __HIP_MEMORY_SCOPE_WORKGROUP); \
                            asm volatile("s_waitcnt lgkmcnt(0)" ::: "memory"); \
                            const unsigned c0 = RAD[127 - 2 * lane], c1 = RAD[126 - 2 * lane], tot = c0 + c1; unsigned incl = wave_scan_incl(tot); \
                            const unsigned excl = incl - tot; const bool win = excl < rem && rem <= incl; \
                            unsigned rr = rem - excl, dg = 127u - 2u * lane; if (rr > c0) { rr -= c0; dg = 126u - 2u * lane; } \
                            const unsigned long long wm = __ballot(win); const int wl = wm ? (int)__ffsll((long long)wm) - 1 : 0; \
                            dg = (unsigned)__builtin_amdgcn_readlane((int)dg, wl); rem = (unsigned)__builtin_amdgcn_readlane((int)rr, wl); prefix = (prefix << 7) | dg; \
                            asm volatile("s_waitcnt lgkmcnt(0)" ::: "memory"); } \
                        const unsigned tk = prefix; bool eqv[NE_]; \
                        _Pragma("unroll") \
                        for (int e = 0; e < NE_; ++e) { eqv[e] = cv[e] && ck[e] == tk; if (cv[e] && ck[e] > tk) __hip_atomic_fetch_or(&selq[ci[e] >> 5], 1u << (ci[e] & 31u), __ATOMIC_RELAXED, __HIP_MEMORY_SCOPE_WORKGROUP); } \
                        for (unsigned k = 0; k < rem; ++k) { unsigned best = 0xffffffffu; \
                        _Pragma("unroll") \
                            for (int e = 0; e < NE_; ++e) if (eqv[e] && ci[e] < best) best = ci[e]; \
                            const unsigned wmn = wave_umin(best); \
                        _Pragma("unroll") \
                            for (int e = 0; e < NE_; ++e) if (eqv[e] && ci[e] == wmn) eqv[e] = false; \
                            if (lane == 0 && wmn < 8192u) __hip_atomic_fetch_or(&selq[wmn >> 5], 1u << (wmn & 31u), __ATOMIC_RELAXED, __HIP_MEMORY_SCOPE_WORKGROUP); } \
                        } while (0)
                        if (nc <= 128u) DSA_CAND_SELECT(2); else DSA_CAND_SELECT(6);
#undef DSA_CAND_SELECT
                    }
                    asm volatile("s_waitcnt lgkmcnt(0)" ::: "memory");
                    if (mode != MODE_OVER) mask_to_list(selq, LIST + q * 256, (LAS unsigned short*)RAD + 2 * lane, lane);
                }
                __syncthreads();
#if !defined(X_NOFB)
                if (META[MT_LCNT * 32] != 0u)
#pragma unroll 1
                for (int q = 0; q < 32; ++q) if (META[MT_MODE * 32 + q] == MODE_OVER) dsa_select_wg(PF, (int)(rb + t0 + q), F.lds, LIST + q * 256, tid, lane, wave);
#endif
                __syncthreads();
                { typedef unsigned u32x8v __attribute__((ext_vector_type(8))); const int qcp = tid >> 4, pc = tid & 15;
                  *(GAS u32x8v*)(LISTG + (rb + t0 + qcp) * 256 + 16 * pc) = *(const LAS u32x8v*)(LIST + qcp * 256 + 16 * pc); }
            }
        }
    asm volatile("s_waitcnt vmcnt(0)" ::: "memory");
    __syncthreads();
    __builtin_amdgcn_fence(__ATOMIC_ACQUIRE, "agent");
    asm volatile("s_waitcnt vmcnt(0)" ::: "memory");
    for (int w = F.vb; w < 256; w += F.G)
        for (int part = 0; part < 4; ++part) {
            const int b = w >> 6, j = w & 63, qt = (part == 0) ? j : (part == 1) ? 127 - j : (part == 2) ? 128 + j : 255 - j, t0 = qt * 32;
            const size_t rb = (size_t)b * T;
#if !defined(X_NOATT)
            for (int rep4 = 0; rep4 <= ((DSADUP >> 3) & 1); ++rep4)
            {
              LAS unsigned char* Vimg = F.lds + wave * 16384;
              typedef unsigned u32x2v __attribute__((ext_vector_type(2)));
              const bool all = (qt < 8);
              u32x2v lwn = (u32x2v){0u, 0u};
              if (!all) lwn = *(const GAS u32x2v*)(LISTG + (rb + t0 + 4 * wave) * 256 + 4 * I.lane);
#pragma unroll 1
              for (int qq = 0; qq < 4; ++qq) { const int q = 4 * wave + qq, t = t0 + q, nk = t + 1, nsel = nk < 256 ? nk : 256; const size_t m = rb + t;
                int lane_ = I.lane; asm volatile("" : "+v"(lane_)); const int lane = lane_, col = lane & 15, g = lane >> 4;
                LAS unsigned short* lq = (LAS unsigned short*)(Vimg + 8192);
                LAS float* bqt = (LAS float*)(Vimg + 8192 + 512);
                { int s4[4];
                  if (!all) { const u32x2v lw = lwn; if (qq < 3) lwn = *(const GAS u32x2v*)(LISTG + (m + 1) * 256 + 4 * lane);
                      *(LAS u32x2v*)(lq + 4 * lane) = lw; s4[0] = (int)(lw.x & 0xffffu); s4[1] = (int)(lw.x >> 16); s4[2] = (int)(lw.y & 0xffffu); s4[3] = (int)(lw.y >> 16); }
                  else {
#pragma unroll
                      for (int e = 0; e < 4; ++e) s4[e] = 4 * lane + e; }
#pragma unroll
                  for (int hh = 0; hh < 4; ++hh) { f32x4 bv;
#pragma unroll
                      for (int e = 0; e < 4; ++e) { const int dd = t - s4[e]; const float bb = biasC[hh * 128 + (dd < 0 ? 0 : (dd > 127 ? 127 : dd))]; bv[e] = (4 * lane + e < nsel) ? bb : -INFINITY; }
                      *(LAS f32x4*)(bqt + hh * 256 + 4 * lane) = bv; } }
                bf16x8 qf[2];
#pragma unroll
                for (int ks = 0; ks < 2; ++ks) { qf[ks] = (bf16x8){0, 0, 0, 0, 0, 0, 0, 0}; if (col < 4) qf[ks] = *(const GAS bf16x8*)(P + m * NP + C_QC + col * 64 + 32 * ks + 8 * g); }
                float mr = -1e30f, l = 0.f; f32x4 o[4];
#pragma unroll
                for (int dt = 0; dt < 4; ++dt) o[dt] = (f32x4){0.f, 0.f, 0.f, 0.f};
                const int nch = (nsel + 31) >> 5;
                bf16x8 kA[4], kB[4]; v4u vA[4], vB[4];
#define DSA_LOAD(ci_, KR, VR) do { const int c0_ = 32 * (ci_); unsigned ik_[2], iv_[4]; \
                    if (all) { _Pragma("unroll") for (int T_ = 0; T_ < 2; ++T_) { const int slot = c0_ + 16 * T_ + col; ik_[T_] = slot < nsel ? (unsigned)slot : 0u; } \
                               _Pragma("unroll") for (int ii = 0; ii < 4; ++ii) { const int slot = c0_ + 8 * ii + (lane >> 3); iv_[ii] = slot < nsel ? (unsigned)slot : 0u; } } \
                    else { _Pragma("unroll") for (int T_ = 0; T_ < 2; ++T_) ik_[T_] = lq[c0_ + 16 * T_ + col]; \
                           _Pragma("unroll") for (int ii = 0; ii < 4; ++ii) iv_[ii] = lq[c0_ + 8 * ii + (lane >> 3)]; } \
                    _Pragma("unroll") for (int T_ = 0; T_ < 2; ++T_) { const bf16* kr = KC + (rb + ik_[T_]) * 64 + 8 * g; KR[2 * T_] = *(const GAS bf16x8*)kr; KR[2 * T_ + 1] = *(const GAS bf16x8*)(kr + 32); } \
                    _Pragma("unroll") for (int ii = 0; ii < 4; ++ii) VR[ii] = *(const GAS v4u*)(VC + (rb + iv_[ii]) * 64 + 8 * ((lane & 7) ^ (lane >> 3))); } while (0)
#define DSA_CHUNK(ci_, KR, VR, FIRST) do { LAS unsigned char* vb_ = Vimg + ((ci_) & 1) * 4096; \
                    _Pragma("unroll") for (int ii = 0; ii < 4; ++ii) *(LAS v4u*)(vb_ + ii * 1024 + lane * 16) = VR[ii]; \
                    const f32x4 bq0 = *(const LAS f32x4*)(bqt + (col & 3) * 256 + 32 * (ci_) + 4 * g), bq1 = *(const LAS f32x4*)(bqt + (col & 3) * 256 + 32 * (ci_) + 16 + 4 * g); \
                      \
                    f32x4 s0 = (FIRST) ? bq0 : bq0 - mr, s1 = (FIRST) ? bq1 : bq1 - mr; \
                    _Pragma("unroll") for (int ks = 0; ks < 2; ++ks) { s0 = __builtin_amdgcn_mfma_f32_16x16x32_bf16(KR[ks], qf[ks], s0, 0, 0, 0); s1 = __builtin_amdgcn_mfma_f32_16x16x32_bf16(KR[2 + ks], qf[ks], s1, 0, 0, 0); } \
                    float mx = fmaxf(fmaxf(fmaxf(s0[0], s0[1]), fmaxf(s0[2], s0[3])), fmaxf(fmaxf(s1[0], s1[1]), fmaxf(s1[2], s1[3]))); \
                    mx = xor32_max(xor16_max(mx)); \
                    if (FIRST) { mr = mx; s0 = s0 - mx; s1 = s1 - mx; }                     \
                    else if (__any(mx > 0.f)) { const float d = fmaxf(mx, 0.f), al = __builtin_amdgcn_exp2f(-d); l *= al; _Pragma("unroll") for (int dt = 0; dt < 4; ++dt) o[dt] = o[dt] * al; mr += d; s0 = s0 - d; s1 = s1 - d; } \
                    _Pragma("unroll") for (int i = 0; i < 4; ++i) { s0[i] = __builtin_amdgcn_exp2f(s0[i]); s1[i] = __builtin_amdgcn_exp2f(s1[i]); } \
                    { const f32x4 r4 = s0 + s1; l += (r4[0] + r4[1]) + (r4[2] + r4[3]); } \
                    v4u pw; pw.x = cvtpk(s0[0], s0[1]); pw.y = cvtpk(s0[2], s0[3]); pw.z = cvtpk(s1[0], s1[1]); pw.w = cvtpk(s1[2], s1[3]); \
                    const bf16x8 pf = __builtin_bit_cast(bf16x8, pw); \
                    const int vrow = 4 * g + ((lane & 15) >> 2), vr7 = vrow & 7; \
                    s16x4 va_[4], vb2_[4]; \
                    _Pragma("unroll") for (int dt = 0; dt < 4; ++dt) { const LAS unsigned char* vp = vb_ + vrow * 128 + (((2 * dt + ((lane & 3) >> 1)) ^ vr7) << 4) + (lane & 1) * 8; va_[dt] = vtr(vp); vb2_[dt] = vtr(vp + 16 * 128); } \
                    _Pragma("unroll") for (int dt = 0; dt < 4; ++dt) { const bf16x8 vf = (bf16x8){va_[dt][0], va_[dt][1], va_[dt][2], va_[dt][3], vb2_[dt][0], vb2_[dt][1], vb2_[dt][2], vb2_[dt][3]}; \
                        o[dt] = __builtin_amdgcn_mfma_f32_16x16x32_bf16(vf, pf, o[dt], 0, 0, 0); } } while (0)
                DSA_LOAD(0, kA, vA);
                if (nch > 1) DSA_LOAD(1, kB, vB);
                DSA_CHUNK(0, kA, vA, true);
                if (2 < nch) DSA_LOAD(2, kA, vA);
                if (1 < nch) { DSA_CHUNK(1, kB, vB, false); if (3 < nch) DSA_LOAD(3, kB, vB); }
#pragma unroll 1
                for (int ci = 2; ci < nch; ci += 2) {
                    DSA_CHUNK(ci, kA, vA, false);
                    if (ci + 2 < nch) DSA_LOAD(ci + 2, kA, vA);
                    if (ci + 1 < nch) { DSA_CHUNK(ci + 1, kB, vB, false); if (ci + 3 < nch) DSA_LOAD(ci + 3, kB, vB); }
                }
#undef DSA_LOAD
#undef DSA_CHUNK
                l = xor32_sum(xor16_sum(l));
                if (col < 4) { typedef unsigned u32x2v __attribute__((ext_vector_type(2))); const float inv = 1.0f / l; bf16* dst = ATT + m * D + 768 + col * 64 + 4 * g;
#pragma unroll
                    for (int dt = 0; dt < 4; ++dt) { u32x2v w2; w2.x = cvtpk(o[dt][0] * inv, o[dt][1] * inv); w2.y = cvtpk(o[dt][2] * inv, o[dt][3] * inv); *(GAS u32x2v*)(dst + 16 * dt) = w2; } }
              } }
#endif
        }
    __syncthreads();
}
__device__ __forceinline__ void swa_phase(Frame& F, ArgsCP kp, int l) {
    LOAD_ARGS(A, kp);
    const Ids I = phase_ids(); const int tid = I.tid, lane = I.lane, wave = I.wave, r32 = lane & 31, hi = lane >> 5;
    const bf16* P = (const bf16*)(A.ws + WS_ACT); bf16* ATT = (bf16*)(A.ws + WS_ATT);
    LAS unsigned char* Kimg = F.lds; LAS unsigned char* Vimg = F.lds + 32768;
    LAS float* biasA = (LAS float*)(F.lds + 65536);
    __syncthreads();
    for (int i = tid; i < 8 * 128; i += NWAVES * 64) { const int h = i >> 7, d = i & 127; biasA[i] = A.rbt[t5_bucket(d) * 16 + h] * LOG2E; }
    for (int u = blockIdx.x; u < BATCH * 2 * 64; u += F.G) {
        const int b = u >> 7, kvh = (u >> 6) & 1, qb = u & 63; const size_t rb = (size_t)b * T;
        const int srow0 = qb * 128 - 128;
        __syncthreads();
        { const size_t r0 = rb + (size_t)(srow0 < 0 ? 0 : srow0);
          stage_kv<256>(P + r0 * NP + C_KA + kvh * 64, P + r0 * NP + C_VA + kvh * 64, NP, Kimg, Vimg, wave, lane); }
        asm volatile("s_waitcnt vmcnt(0)" ::: "memory");
        __syncthreads();
        const int g = wave >> 1, hq = kvh * 4 + g; const float sink2 = A.sinks[l * 8 + hq] * LOG2E;
        const int ishift = srow0 < 0 ? 128 : 0;
#pragma unroll 1
        for (int sub = 0; sub < 2; ++sub) {
            const int tl = 64 * (wave & 1) + 32 * sub, tq = qb * 128 + tl + r32;
            bf16x8 qf[4];
#pragma unroll
            for (int s = 0; s < 4; ++s) qf[s] = *(const GAS bf16x8*)(P + (rb + tq) * NP + C_QA + hq * 64 + 16 * s + 8 * hi);
            float m = sink2, lsum = hi == 0 ? 1.0f : 0.f; f32x16 o0, o1;
#pragma unroll
            for (int i = 0; i < 16; ++i) { o0[i] = 0.f; o1[i] = 0.f; }
            const int j0 = (tl >> 5);
#pragma unroll 1
            for (int jt = 0; jt < 5; ++jt) {
                const int s0 = srow0 + 32 * (j0 + jt);
                if (s0 < 0) continue;
                const int k0 = 32 * (j0 + jt) - ishift;
                f32x16 sc = qk_tile(Kimg, 256, k0, qf, r32, hi, 0.f);
#pragma unroll
                for (int i = 0; i < 16; ++i) { const int dd = tq - (s0 + crow(i, hi)); const bool ok = dd >= 0 && dd < 128; const float v = sc[i] + biasA[hq * 128 + (ok ? dd : 0)]; sc[i] = ok ? v : -INFINITY; }
                softmax_pv(sc, Vimg, 256, k0, lane, m, lsum, o0, o1);
            }
            lsum += __shfl_xor(lsum, 32);
            store_ot(ATT + (rb + tq) * D + hq * 64, o0, o1, 1.0f / lsum, hi);
        }
    }
    __syncthreads();
}
__device__ __forceinline__ void rm_issue32(const bf16* row0, size_t ld, LAS unsigned char* img, int lane) {
    const bf16* src = row0 + (size_t)(lane >> 3) * ld + 8 * ((lane & 7) ^ (lane >> 3));
#pragma unroll
    for (int i = 0; i < 4; ++i) ATT_DMA16(src + (size_t)(8 * i) * ld, img + i * 1024);
}
__device__ __forceinline__ f32x16 qk_tile_rm(const LAS unsigned char* img, const bf16x8 (&qf)[4], int r32, int hi, float cinit) {
    f32x16 acc;
#pragma unroll
    for (int i = 0; i < 16; ++i) acc[i] = cinit;
#pragma unroll
    for (int s = 0; s < 4; ++s) { const bf16x8 kf = *(const LAS bf16x8*)(img + r32 * 128 + (((2 * s + hi) ^ (r32 & 7)) << 4)); acc = __builtin_amdgcn_mfma_f32_32x32x16_bf16(kf, qf[s], acc, 0, 0, 0); }
    return acc;
}
__device__ __forceinline__ void softmax_pv_rm(f32x16 sc, const LAS unsigned char* vimg, int lane, float& m, float& l, f32x16& o0, f32x16& o1) {
    float mx = sc[0];
#pragma unroll
    for (int i = 1; i < 16; ++i) mx = fmaxf(mx, sc[i]);
    mx = xor32_max(mx);
    const float mn = fmaxf(m, mx);
    if (__any(mn > m)) { const float al = __builtin_amdgcn_exp2f(m - mn); l *= al; o0 = o0 * al; o1 = o1 * al; m = mn; }
    float rs = 0.f;
#pragma unroll
    for (int i = 0; i < 16; ++i) { sc[i] = __builtin_amdgcn_exp2f(sc[i] - mn); rs += sc[i]; }
    l += rs;
    bf16x8 pf[2];
#pragma unroll
    for (int s = 0; s < 2; ++s) { v4u w; w.x = cvtpk(sc[8 * s], sc[8 * s + 1]); w.y = cvtpk(sc[8 * s + 2], sc[8 * s + 3]); w.z = cvtpk(sc[8 * s + 4], sc[8 * s + 5]); w.w = cvtpk(sc[8 * s + 6], sc[8 * s + 7]); pf[s] = __builtin_bit_cast(bf16x8, w); }
    const int hi = lane >> 5, rl = 4 * hi + ((lane & 15) >> 2), rh = (lane >> 4) & 1, p = lane & 3;
#pragma unroll
    for (int dh = 0; dh < 2; ++dh) { const LAS unsigned char* vb = vimg + rl * 128 + (((4 * dh + 2 * rh + (p >> 1)) ^ rl) << 4) + (p & 1) * 8;
#pragma unroll
        for (int s = 0; s < 2; ++s) { const s16x4 a = vtr(vb + (16 * s) * 128), b = vtr(vb + (16 * s + 8) * 128);
            const bf16x8 vf = (bf16x8){a[0], a[1], a[2], a[3], b[0], b[1], b[2], b[3]};
            if (dh == 0) o0 = __builtin_amdgcn_mfma_f32_32x32x16_bf16(vf, pf[s], o0, 0, 0, 0); else o1 = __builtin_amdgcn_mfma_f32_32x32x16_bf16(vf, pf[s], o1, 0, 0, 0); } }
}
__device__ __forceinline__ void softmax_pv_rm_pre(f32x16 sc, const LAS unsigned char* vimg, int lane, float& m, float& l, f32x16& o0, f32x16& o1) {
    typedef float f32x2 __attribute__((ext_vector_type(2)));
    float mx = sc[0];
#pragma unroll
    for (int i = 1; i < 16; ++i) mx = fmaxf(mx, sc[i]);
    mx = xor32_max(mx);
    if (__any(mx > 0.f)) { const float d = fmaxf(mx, 0.f), al = __builtin_amdgcn_exp2f(-d); l *= al; o0 = o0 * al; o1 = o1 * al; m += d;
#pragma unroll
        for (int i = 0; i < 16; ++i) sc[i] -= d; }
    f32x2 rs2 = (f32x2){0.f, 0.f};
#pragma unroll
    for (int i = 0; i < 16; i += 2) { sc[i] = __builtin_amdgcn_exp2f(sc[i]); sc[i + 1] = __builtin_amdgcn_exp2f(sc[i + 1]); rs2 += (f32x2){sc[i], sc[i + 1]}; }
    l += rs2.x + rs2.y;
    bf16x8 pf[2];
#pragma unroll
    for (int s = 0; s < 2; ++s) { v4u w; w.x = cvtpk(sc[8 * s], sc[8 * s + 1]); w.y = cvtpk(sc[8 * s + 2], sc[8 * s + 3]); w.z = cvtpk(sc[8 * s + 4], sc[8 * s + 5]); w.w = cvtpk(sc[8 * s + 6], sc[8 * s + 7]); pf[s] = __builtin_bit_cast(bf16x8, w); }
    const int hi = lane >> 5, rl = 4 * hi + ((lane & 15) >> 2), rh = (lane >> 4) & 1, p = lane & 3;
#pragma unroll
    for (int dh = 0; dh < 2; ++dh) { const LAS unsigned char* vb = vimg + rl * 128 + (((4 * dh + 2 * rh + (p >> 1)) ^ rl) << 4) + (p & 1) * 8;
#pragma unroll
        for (int s = 0; s < 2; ++s) { const s16x4 a = vtr(vb + (16 * s) * 128), b = vtr(vb + (16 * s + 8) * 128);
            const bf16x8 vf = (bf16x8){a[0], a[1], a[2], a[3], b[0], b[1], b[2], b[3]};
            if (dh == 0) o0 = __builtin_amdgcn_mfma_f32_32x32x16_bf16(vf, pf[s], o0, 0, 0, 0); else o1 = __builtin_amdgcn_mfma_f32_32x32x16_bf16(vf, pf[s], o1, 0, 0, 0); } }
}
constexpr int MB_UP = 131584, MB_BIAS = MB_UP, MB_SELM = MB_BIAS + 512, MB_CNT = MB_SELM + 1024, MB_NIT = MB_CNT + 128, MB_ITEMS = MB_NIT + 16, MB_LIST = MB_ITEMS + 512, MB_END = MB_LIST + 8192;
static_assert(MB_END <= LDSCTL_OFF, "MoBA LDS map");
constexpr int MB_PART_STRIDE = 80;
constexpr size_t MB_PART_WG = (size_t)256 * 4 * 2 * MB_PART_STRIDE;
__device__ __forceinline__ void moba_bucket_phase(Frame& F, ArgsCP kp) {
    LOAD_ARGS(A, kp);
    const Ids I = phase_ids(); const int tid = I.tid, lane = I.lane, wave = I.wave, r32 = lane & 31, hi = lane >> 5;
    const bf16* P = (const bf16*)(A.ws + WS_ACT); bf16* ATT = (bf16*)(A.ws + WS_ATT); const float* KMEAN = (const float*)(A.ws + WS_KMEAN);
    unsigned char* PART = (unsigned char*)A.out + (size_t)blockIdx.x * MB_PART_WG;
    LAS float* biasB = (LAS float*)(F.lds + MB_BIAS); LAS unsigned* selm = (LAS unsigned*)(F.lds + MB_SELM); LAS unsigned* CNT = (LAS unsigned*)(F.lds + MB_CNT);
    LAS unsigned* NIT = (LAS unsigned*)(F.lds + MB_NIT); LAS unsigned* ITEMS = (LAS unsigned*)(F.lds + MB_ITEMS); LAS unsigned char* LISTJ = F.lds + MB_LIST;
    LAS unsigned char* WB = F.lds + wave * 16384;
    for (int w = F.vb; w < 256; w += F.G)
        for (int half = 0; half < 2; ++half) {
            const int bh = w >> 4, ob = half ? 31 - (w & 15) : (w & 15), b = bh >> 2, h = bh & 3;
            const size_t rb = (size_t)b * T;
            __syncthreads();
            if (tid < 128) biasB[tid] = A.rbt[t5_bucket(tid) * 16 + 8 + h] * LOG2E;
            { LAS float* KM = (LAS float*)(F.lds + 8192); LAS float* GP = (LAS float*)F.lds;
              for (int i = tid; i < ob * 16; i += NWAVES * 64) ((LAS f32x4*)KM)[i] = ((const GAS f32x4*)(KMEAN + (size_t)bh * 32 * 64))[i];
              const int gq = tid & 255, part = tid >> 8;
              const bf16* qp = P + (rb + ob * 256 + gq) * NP + C_QB + h * 64; float qv[64];
#pragma unroll
              for (int c = 0; c < 8; ++c) { const v4u qw = *(const GAS v4u*)(qp + 8 * c); float t8[8]; unpack8(qw, t8);
#pragma unroll
                  for (int e = 0; e < 8; ++e) qv[8 * c + e] = t8[e]; }
              __syncthreads();
              float v0 = -INFINITY, v1 = -INFINITY, v2 = -INFINITY; int i0 = -1, i1 = -1, i2 = -1;
              for (int n = part; n < ob; n += 2) { const LAS f32x4* km = (const LAS f32x4*)(KM + n * 64); float g = 0.f;
#pragma unroll
                  for (int c = 0; c < 16; ++c) { const f32x4 k4 = km[c]; g += qv[4 * c] * k4.x; g += qv[4 * c + 1] * k4.y; g += qv[4 * c + 2] * k4.z; g += qv[4 * c + 3] * k4.w; }
                  if (g > v0) { v2 = v1; i2 = i1; v1 = v0; i1 = i0; v0 = g; i0 = n; } else if (g > v1) { v2 = v1; i2 = i1; v1 = g; i1 = n; } else if (g > v2) { v2 = g; i2 = n; } }
              if (part) { *(LAS f32x4*)(GP + gq * 8) = (f32x4){v0, v1, v2, 0.f}; *(LAS v4u*)(GP + gq * 8 + 4) = (v4u){(unsigned)i0, (unsigned)i1, (unsigned)i2, 0u}; }
              __syncthreads();
              if (!part) { const f32x4 bv = *(const LAS f32x4*)(GP + gq * 8); const v4u bi = *(const LAS v4u*)(GP + gq * 8 + 4);
#pragma unroll
                  for (int e = 0; e < 3; ++e) { const float g = e == 0 ? bv.x : e == 1 ? bv.y : bv.z; const int n = (int)(e == 0 ? bi.x : e == 1 ? bi.y : bi.z);
                      if (g > v0 || (g == v0 && n < i0)) { v2 = v1; i2 = i1; v1 = v0; i1 = i0; v0 = g; i0 = n; } else if (g > v1 || (g == v1 && n < i1)) { v2 = v1; i2 = i1; v1 = g; i1 = n; } else if (g > v2 || (g == v2 && n < i2)) { v2 = g; i2 = n; } }
                  unsigned msk = 0u; if (i0 >= 0) msk |= 1u << i0; if (i1 >= 0) msk |= 1u << i1; if (i2 >= 0) msk |= 1u << i2;
                  selm[gq] = msk; } }
            __syncthreads();
            for (int j = wave; j < ob; j += NWAVES) { unsigned base = 0u;
#pragma unroll
                for (int c = 0; c < 4; ++c) { const int q = 64 * c + lane; const bool bit = (selm[q] >> j) & 1u; const unsigned long long mask = __ballot(bit);
                    if (bit) LISTJ[j * 256 + base + (unsigned)__popcll(mask & ((1ull << lane) - 1ull))] = (unsigned char)q; base += (unsigned)__popcll(mask); }
                if (lane == 0) CNT[j] = base; }
            __syncthreads();
            if (wave == 0) {
                const unsigned ng = (lane < ob) ? ((CNT[lane] + 31u) >> 5) : 0u; unsigned incl = wave_scan_incl(ng);
                const unsigned excl = incl - ng, npast = (unsigned)__builtin_amdgcn_readlane((int)incl, 63);
                for (unsigned g = 0; g < ng; ++g) ITEMS[excl + g] = (unsigned)lane * 8u + g;
                if (lane < 8) ITEMS[npast + lane] = 32u * 8u + (unsigned)(7 - lane);
                if (lane == 63) { NIT[0] = 8u + incl; NIT[1] = 0u; } }
            __syncthreads();
            const int nit = (int)NIT[0]; const float b31 = biasB[127];
#define MB_FETCH(KN, ITN, VALIDN, QIDN, QFN) do { int k_ = 0; if (lane == 0) k_ = (int)__hip_atomic_fetch_add(&NIT[1], 1u, __ATOMIC_RELAXED, __HIP_MEMORY_SCOPE_WORKGROUP); KN = __builtin_amdgcn_readfirstlane(k_); \
                if (KN < nit) { ITN = ITEMS[KN]; const int j_ = (int)(ITN >> 3), g_ = (int)(ITN & 7u); const bool own_ = (j_ == 32); \
                    VALIDN = own_ ? true : ((unsigned)(32 * g_ + r32) < CNT[own_ ? 0 : j_]); QIDN = own_ ? 32 * g_ + r32 : (VALIDN ? (int)LISTJ[(own_ ? 0 : j_) * 256 + 32 * g_ + r32] : 0); \
                    _Pragma("unroll") for (int s = 0; s < 4; ++s) QFN[s] = *(const GAS bf16x8*)(P + (rb + ob * 256 + QIDN) * NP + C_QB + h * 64 + 16 * s + 8 * hi); } } while (0)
            int kn; unsigned itn = 0u; bool validn = false; int qidn = 0; bf16x8 qfn[4];
            MB_FETCH(kn, itn, validn, qidn, qfn);
#pragma unroll 1
            while (kn < nit) {
                const unsigned it = itn; const int j = (int)(it >> 3), g = (int)(it & 7u); const bool own = (j == 32);
                const int jb = own ? ob : j;
                const bool valid = validn; const int qid = qidn;
                const int tq = ob * 256 + qid;
                bf16x8 qf[4];
#pragma unroll
                for (int s = 0; s < 4; ++s) qf[s] = qfn[s];
                const int ntile = own ? g + 1 : 8; const bool cb = !own && (jb + 1 < ob);
                const bf16* Kg = P + (rb + (size_t)jb * 256) * NP + C_KB + h * 64; const bf16* Vg = P + (rb + (size_t)jb * 256) * NP + C_VB + h * 64;
                float m = -1e30f, l = 0.f; f32x16 o0, o1;
#pragma unroll
                for (int i = 0; i < 16; ++i) { o0[i] = 0.f; o1[i] = 0.f; }
                asm volatile("s_waitcnt lgkmcnt(0)" ::: "memory");
                rm_issue32(Kg, NP, WB, lane); rm_issue32(Vg, NP, WB + 4096, lane);
#define MB_TILE(kt_, FIRST) do { \
                    asm volatile("s_waitcnt lgkmcnt(0)" ::: "memory");                    \
                    if ((kt_) + 1 < ntile) { LAS unsigned char* nb = WB + (((kt_) + 1) & 1) * 8192; rm_issue32(Kg + (size_t)((kt_) + 1) * 32 * NP, NP, nb, lane); rm_issue32(Vg + (size_t)((kt_) + 1) * 32 * NP, NP, nb + 4096, lane); \
                        asm volatile("s_waitcnt vmcnt(8)" ::: "memory"); } else { asm volatile("s_waitcnt vmcnt(0)" ::: "memory"); } \
                    if (FIRST) MB_FETCH(kn, itn, validn, qidn, qfn);                      \
                    const LAS unsigned char* kb = WB + ((kt_) & 1) * 8192; \
                    f32x16 sc = qk_tile_rm(kb, qf, r32, hi, (cb ? b31 : 0.f) - ((FIRST) ? 0.f : m)); \
                    if (!cb) { int hl_ = hi; asm volatile("" : "+v"(hl_)); const int db_ = tq - (jb * 256 + (kt_) * 32) - 4 * hl_;     \
                        _Pragma("unroll") for (int i = 0; i < 16; ++i) { const int dd = db_ - ((i & 3) + 8 * (i >> 2)); const int dc = dd < 0 ? 0 : (dd > 127 ? 127 : dd); const float v = sc[i] + biasB[dc]; sc[i] = dd < 0 ? -INFINITY : v; } } \
                    if (FIRST) softmax_pv_rm(sc, kb + 4096, lane, m, l, o0, o1); else softmax_pv_rm_pre(sc, kb + 4096, lane, m, l, o0, o1); } while (0)
                MB_TILE(0, true);
#pragma unroll 1
                for (int kt = 1; kt < ntile; ++kt) MB_TILE(kt, false);
#undef MB_TILE
                if (valid) {
                    const int slot = own ? 3 : __popc(selm[qid] & ((1u << j) - 1u));
                    unsigned char* pp = PART + ((size_t)(slot * 5) * 512 + (size_t)(qid * 2 + hi)) * 16;
                    typedef float f32x2v __attribute__((ext_vector_type(2)));
                    *(GAS f32x2v*)pp = (f32x2v){m, l};
#pragma unroll
                    for (int c = 0; c < 4; ++c) { v4u w4; const f32x16& oo = (c < 2) ? o0 : o1; const int e0 = 8 * (c & 1);
                        w4.x = cvtpk(oo[e0], oo[e0 + 1]); w4.y = cvtpk(oo[e0 + 2], oo[e0 + 3]); w4.z = cvtpk(oo[e0 + 4], oo[e0 + 5]); w4.w = cvtpk(oo[e0 + 6], oo[e0 + 7]); *(GAS v4u*)(pp + (size_t)(c + 1) * 8192) = w4; } }
            }
            asm volatile("s_waitcnt vmcnt(0)" ::: "memory");
            __syncthreads();
            __builtin_amdgcn_fence(__ATOMIC_ACQUIRE, "agent");
            asm volatile("s_waitcnt vmcnt(0)" ::: "memory");
#ifdef MB_XMERGE
            for (int rep_ = 0; rep_ < 2; ++rep_)
#endif
            {
                const int qid = 32 * wave + r32, tq = ob * 256 + qid; const int nsel = __popc(selm[qid]);
                float ms[4], ls[4]; float M = -1e30f;
#pragma unroll
                for (int s = 0; s < 4; ++s) { const bool on = (s == 3) || (s < nsel); typedef float f32x2v __attribute__((ext_vector_type(2)));
                    const unsigned char* pp = PART + ((size_t)(s * 5) * 512 + (size_t)(qid * 2 + hi)) * 16; f32x2v ml = *(const GAS f32x2v*)pp; if (!on) ml = (f32x2v){-1e30f, 0.f};
                    ms[s] = ml.x; ls[s] = ml.y; M = fmaxf(M, ml.x); }
                float lt = 0.f; float acc[32];
#pragma unroll
                for (int e = 0; e < 32; ++e) acc[e] = 0.f;
                v4u pw4[4][4];
#pragma unroll
                for (int s = 0; s < 4; ++s) { const unsigned char* pp = PART + ((size_t)(s * 5) * 512 + (size_t)(qid * 2 + hi)) * 16;
#pragma unroll
                    for (int c = 0; c < 4; ++c) pw4[s][c] = *(const GAS v4u*)(pp + (size_t)(c + 1) * 8192); }
#pragma unroll
                for (int s = 0; s < 4; ++s) { const bool on = (s == 3) || (s < nsel); const float f = on ? __builtin_amdgcn_exp2f(ms[s] - M) : 0.f; lt += ls[s] * f;
#pragma unroll
                    for (int c = 0; c < 4; ++c) { v4u w4 = pw4[s][c]; if (!on) w4 = (v4u){0u, 0u, 0u, 0u}; float t8[8]; unpack8(w4, t8);
#pragma unroll
                        for (int e = 0; e < 8; ++e) acc[8 * c + e] += t8[e] * f; } }
                lt += __shfl_xor(lt, 32); const float inv = 1.0f / lt;
                f32x16 o0, o1;
#pragma unroll
                for (int e = 0; e < 16; ++e) { o0[e] = acc[e]; o1[e] = acc[16 + e]; }
                store_ot(ATT + (rb + tq) * D + 512 + h * 64, o0, o1, inv, hi);
            }
        }
    __syncthreads();
}
constexpr int N_PHASES = 18;
struct LimitOrder : pg8::StaticOrder { int lim; __device__ bool next(int i, pg8::Unit& u) const { if (i >= lim) return false; return pg8::StaticOrder::next(i, u); } };
#ifndef EN_SWA
#define EN_SWA 2
#endif
#ifndef EN_MOBA
#define EN_MOBA 3
#endif
#ifndef EN_DSA
#define EN_DSA 2
#endif
#ifndef DUP
#define DUP 0
#endif
#ifndef GEMM_SP2
#define GEMM_SP2 true
#endif
#ifndef RESID_ALIGN
#define RESID_ALIGN true
#endif
#ifndef PHMASK
#define PHMASK 0x3ff
#endif
__global__ void __launch_bounds__(NWAVES * 64, 2) mega_fwd(Args args_unused) {
    extern __shared__ __attribute__((aligned(16))) unsigned char lds[];
    const ArgsCP kp = (ArgsCP)__builtin_amdgcn_kernarg_segment_ptr();
    Frame F;
    F.lds = (LAS unsigned char*)lds; F.MISC = (volatile LAS unsigned*)(F.lds + MISC_OFF);
    F.G = gridDim.x; F.wv = 0; { const int bx = blockIdx.x; F.vb = (F.G % 8 == 0) ? (bx % 8) * (F.G / 8) + bx / 8 : bx; }
    for (int u = threadIdx.x; u < 512 / 4; u += NWAVES * 64) ((LAS unsigned*)(F.lds + LDSCTL_OFF))[u] = 0u;
    __syncthreads();
    const int lo = kp->ph_lo, hi = kp->ph_hi;
    const bool multi = (hi - lo) > 1;
    { unsigned char* ws0 = kp->ws; F.ctl = (gu32*)(ws0 + WS_CTL); }
    XcdBarrier bar; bar.bar = (unsigned*)(F.ctl + CW_BAR); bar.x = 0; bar.st = nullptr;
    if (multi) bar = xcd_barrier_post((unsigned*)(F.ctl + CW_BAR), F.MISC + 8);
#define IN(k) (lo <= (k) && (k) < hi)
#define SEAM(k) do { if (IN(k) && IN((k) + 1)) { XcdBarrier b2_ = bar; asm volatile("" : "+s"(b2_.bar)); xcd_barrier(b2_); if ((DUP >> 12) & 1) xcd_barrier(b2_); } } while (0)
#define WSP(type, name, off) type* name = (type*)(A.ws + (off))
    if (((PHMASK >> 8) & 1) && IN(0)) { p0_prologue(F, kp); if ((DUP >> 8) & 1) { __syncthreads(); p0_prologue(F, kp); } }
    SEAM(0);
    for (int l = 0; l < DEPTH; ++l) {
        const int pb = 1 + 8 * l;
        int bx_l = (int)blockIdx.x; asm volatile("" : "+s"(bx_l));
        int lo_l = lo, hi_l = hi; asm volatile("" : "+s"(lo_l), "+s"(hi_l));
#undef IN
#define IN(k) (lo_l <= (k) && (k) < hi_l)
        if (((PHMASK >> 0) & 1) && IN(pb + 0)) { LOAD_ARGS(A, kp); WSP(bf16, XB, WS_XB); WSP(float, SS, WS_SS); WSP(bf16, ACT, WS_ACT); const bf16* Wt = (const bf16*)(A.ws + WS_W + (size_t)l * W_LAYER + WO_GU1);
            pg8::Gemm g{XB, Wt, M, NGU, D}; pg8::StaticOrder S; S.init(M, NGU, F.G, bx_l);
            pg8::EpiSwiGLU E{ACT, FF, SS}; pg8::gemm_phase<pg8::EpiSwiGLU, pg8::StaticOrder, true, GEMM_SP2, true>(F.lds + RING_OFF, g, S, E);
            if ((DUP >> 0) & 1) pg8::gemm_phase<pg8::EpiSwiGLU, pg8::StaticOrder, true, GEMM_SP2, true>(F.lds + RING_OFF, g, S, E); }
        SEAM(pb + 0);
        if (((PHMASK >> 1) & 1) && IN(pb + 1)) { LOAD_ARGS(A, kp); WSP(bf16, XB, WS_XB); WSP(float, SS, WS_SS); WSP(bf16, ACT, WS_ACT); const bf16* Wt = (const bf16*)(A.ws + WS_W + (size_t)l * W_LAYER + WO_D1);
            pg8::Gemm g{ACT, Wt, M, D, FF}; pg8::StaticOrder S; S.init(M, D, F.G, bx_l);
            if ((DUP >> 1) & 1) { pg8::EpiResid E1{(l == 0) ? A.x : (const float*)nullptr, XB, SS, 0.25f}; pg8::gemm_phase<pg8::EpiResid, pg8::StaticOrder, RESID_ALIGN, GEMM_SP2, true>(F.lds + RING_OFF, g, S, E1); __syncthreads(); asm volatile("s_waitcnt vmcnt(0)" ::: "memory");
                pg8::EpiResid E2{(const float*)nullptr, XB, SS, 0.25f}; pg8::gemm_phase<pg8::EpiResid, pg8::StaticOrder, RESID_ALIGN, GEMM_SP2, true>(F.lds + RING_OFF, g, S, E2); }
            else { pg8::EpiResid E{(l == 0) ? A.x : (const float*)nullptr, XB, SS, 0.5f}; pg8::gemm_phase<pg8::EpiResid, pg8::StaticOrder, RESID_ALIGN, GEMM_SP2, true>(F.lds + RING_OFF, g, S, E); } }
        SEAM(pb + 1);
        if (((PHMASK >> 2) & 1) && IN(pb + 2)) { LOAD_ARGS(A, kp); WSP(bf16, XB, WS_XB); WSP(float, SS, WS_SS); WSP(bf16, Pb, WS_ACT); WSP(float, PF, WS_PF); const bf16* Wt = (const bf16*)(A.ws + WS_W + (size_t)l * W_LAYER + WO_IN);
            pg8::Gemm g{XB, Wt, M, NP, D}; pg8::StaticOrder S; S.init(M, NP, F.G, bx_l);
            pg8::EpiProj E{Pb, PF, SS, QSCALE, (_Float16*)(A.ws + WS_QIH), (_Float16*)(A.ws + WS_KIH)}; pg8::gemm_phase<pg8::EpiProj, pg8::StaticOrder, true, GEMM_SP2, true>(F.lds + RING_OFF, g, S, E);
            if ((DUP >> 2) & 1) pg8::gemm_phase<pg8::EpiProj, pg8::StaticOrder, true, GEMM_SP2, true>(F.lds + RING_OFF, g, S, E);
            if ((DUP >> 10) & 1) { LimitOrder S1; S1.init(M, NP, F.G, bx_l); S1.lim = 1; pg8::gemm_phase<pg8::EpiProj, LimitOrder, true, true, true>(F.lds + RING_OFF, g, S1, E); }
            if ((DUP >> 11) & 1) { LimitOrder S1; S1.init(M, NP, F.G, bx_l); S1.lim = 2; pg8::gemm_phase<pg8::EpiProj, LimitOrder, true, true, true>(F.lds + RING_OFF, g, S1, E); } }
        SEAM(pb + 2);
        if (((PHMASK >> 3) & 1) && IN(pb + 3)) { prep_phase(F, kp, l); if ((DUP >> 3) & 1) { __syncthreads(); prep_phase(F, kp, l); } }
        SEAM(pb + 3);
        if (((PHMASK >> 4) & 1) && IN(pb + 4)) {
#if EN_SWA == 1
            swa_naive(F, kp, l);
#elif EN_SWA == 2
            swa_phase(F, kp, l);
            if ((DUP >> 4) & 1) swa_phase(F, kp, l);
#endif
#if EN_MOBA == 1
            moba_naive(F, kp);
#elif EN_MOBA == 2
            moba_phase(F, kp);
            if ((DUP >> 5) & 1) moba_phase(F, kp);
#elif EN_MOBA == 3
            moba_bucket_phase(F, kp);
            if ((DUP >> 5) & 1) moba_bucket_phase(F, kp);
#endif
#if EN_DSA == 1
            dsa_naive(F, kp);
#elif EN_DSA == 2
            dsa_phase(F, kp);
            if ((DUP >> 6) & 1) dsa_phase(F, kp);
#endif
        }
        SEAM(pb + 4);
        if (((PHMASK >> 5) & 1) && IN(pb + 5)) { LOAD_ARGS(A, kp); WSP(bf16, XB, WS_XB); WSP(float, SS, WS_SS); WSP(bf16, ATT, WS_ATT); const bf16* Wt = (const bf16*)(A.ws + WS_W + (size_t)l * W_LAYER + WO_OUT);
            pg8::Gemm g{ATT, Wt, M, D, D}; pg8::StaticOrder S; S.init(M, D, F.G, bx_l);
            if ((DUP >> 7) & 1) { pg8::EpiResid E1{(const float*)nullptr, XB, SS, 0.5f}; pg8::gemm_phase<pg8::EpiResid, pg8::StaticOrder, RESID_ALIGN, GEMM_SP2>(F.lds + RING_OFF, g, S, E1); __syncthreads(); asm volatile("s_waitcnt vmcnt(0)" ::: "memory");
                pg8::gemm_phase<pg8::EpiResid, pg8::StaticOrder, RESID_ALIGN, GEMM_SP2>(F.lds + RING_OFF, g, S, E1); }
            else { pg8::EpiResid E{(const float*)nullptr, XB, SS, 1.0f}; pg8::gemm_phase<pg8::EpiResid, pg8::StaticOrder, RESID_ALIGN, GEMM_SP2>(F.lds + RING_OFF, g, S, E); } }
        SEAM(pb + 5);
        if (((PHMASK >> 6) & 1) && IN(pb + 6)) { LOAD_ARGS(A, kp); WSP(bf16, XB, WS_XB); WSP(float, SS, WS_SS); WSP(bf16, ACT, WS_ACT); const bf16* Wt = (const bf16*)(A.ws + WS_W + (size_t)l * W_LAYER + WO_GU2);
            pg8::Gemm g{XB, Wt, M, NGU, D}; pg8::StaticOrder S; S.init(M, NGU, F.G, bx_l);
            pg8::EpiSwiGLU E{ACT, FF, SS}; pg8::gemm_phase<pg8::EpiSwiGLU, pg8::StaticOrder, true, GEMM_SP2, true>(F.lds + RING_OFF, g, S, E); }
        SEAM(pb + 6);
        if (((PHMASK >> 7) & 1) && IN(pb + 7)) { LOAD_ARGS(A, kp); WSP(bf16, XB, WS_XB); WSP(float, SS, WS_SS); WSP(bf16, ACT, WS_ACT); const bf16* Wt = (const bf16*)(A.ws + WS_W + (size_t)l * W_LAYER + WO_D2);
            pg8::Gemm g{ACT, Wt, M, D, FF}; pg8::StaticOrder S; S.init(M, D, F.G, bx_l);
            pg8::EpiResid E{(const float*)nullptr, XB, SS, 0.5f}; pg8::gemm_phase<pg8::EpiResid, pg8::StaticOrder, RESID_ALIGN, GEMM_SP2, true>(F.lds + RING_OFF, g, S, E); }
        SEAM(pb + 7);
    }
#undef IN
#define IN(k) (lo <= (k) && (k) < hi)
    if (((PHMASK >> 9) & 1) && IN(17)) { final_phase(F, kp); }
#undef IN
#undef SEAM
#undef WSP
}
#ifndef MK_ONE_LAUNCH
#define MK_ONE_LAUNCH 1
#endif
extern "C" void kernel_launch(void* const* d_in, const int* in_sizes, int n_in, void* d_out, int out_size, void* d_ws, size_t ws_size, hipStream_t stream) {
    static int grid = 0;
    if (grid == 0) {
        if (n_in != 17 || in_sizes[0] != M * D || out_size != M * D || ws_size < WS_END) { fprintf(stderr, "kernel_launch: unexpected shapes (n_in %d, in0 %d, out %d, ws %zu); nothing launched\n", n_in, n_in > 0 ? in_sizes[0] : -1, out_size, ws_size); grid = -1; return; }
        int dev = 0, cus = 0, per_cu = 0;
        if (hipGetDevice(&dev) != hipSuccess || hipDeviceGetAttribute(&cus, hipDeviceAttributeMultiprocessorCount, dev) != hipSuccess) { grid = -1; return; }
        if (hipFuncSetAttribute((const void*)mega_fwd, hipFuncAttributeMaxDynamicSharedMemorySize, LDS_BYTES) != hipSuccess) { fprintf(stderr, "kernel_launch: hipFuncSetAttribute failed\n"); grid = -1; return; }
        if (hipOccupancyMaxActiveBlocksPerMultiprocessor(&per_cu, (const void*)mega_fwd, NWAVES * 64, LDS_BYTES) != hipSuccess || per_cu < 1) { fprintf(stderr, "kernel_launch: occupancy query reports %d blocks per CU\n", per_cu); }
        (void)hipGetLastError();
        grid = cus;
    }
    if (grid < 0) return;
    if (hipMemsetAsync((char*)d_ws + WS_CTL, 0, CTL_ZERO_BYTES, stream) != hipSuccess) return;
    Args a{};
    a.x = (const float*)d_in[0]; a.rbt = (const float*)d_in[1]; a.n1 = (const float*)d_in[2]; a.g1 = (const float*)d_in[3]; a.u1 = (const float*)d_in[4]; a.d1 = (const float*)d_in[5];
    a.nm = (const float*)d_in[6]; a.win = (const float*)d_in[7]; a.sinks = (const float*)d_in[8]; a.kvn = (const float*)d_in[9]; a.wkv = (const float*)d_in[10]; a.wout = (const float*)d_in[11];
    a.n2 = (const float*)d_in[12]; a.g2 = (const float*)d_in[13]; a.u2 = (const float*)d_in[14]; a.d2 = (const float*)d_in[15]; a.nf = (const float*)d_in[16];
    a.out = (float*)d_out; a.ws = (unsigned char*)d_ws;
#if MK_ONE_LAUNCH
    a.ph_lo = 0; a.ph_hi = N_PHASES;
    hipLaunchKernelGGL(mega_fwd, dim3(grid), dim3(NWAVES * 64), LDS_BYTES, stream, a);
#else
    for (int p = 0; p < N_PHASES; ++p) { a.ph_lo = p; a.ph_hi = p + 1; hipLaunchKernelGGL(mega_fwd, dim3(grid), dim3(NWAVES * 64), LDS_BYTES, stream, a); }
#endif
}
```

```cpp
#include <hip/hip_runtime.h>
#include <cstdio>
#include <cstdint>
#include <cmath>
#ifndef PG8_WGM
#define PG8_WGM 8
#endif
namespace pg8 {
#define PG8_LAS __attribute__((address_space(3)))
typedef unsigned short bf16_t;
typedef short bf16x8 __attribute__((ext_vector_type(8)));
typedef float f32x4 __attribute__((ext_vector_type(4)));
typedef unsigned u32x4 __attribute__((ext_vector_type(4)));
constexpr int BM = 256, BK = 64, HALF = 128, HTB = HALF * BK * 2  , STAGE_BYTES = 8 * HTB, NXCD = 8, WGM = PG8_WGM;

__host__ __device__ __forceinline__ int lds_byte(int r, int c) { const int st = (r >> 4) * 2 + (c >> 5), rr = r & 15, cc = c & 31, ob = rr * 64 + cc * 2; return st * 1024 + (ob ^ (((ob >> 9) & 1) << 5)); }
__host__ __device__ __forceinline__ void stage_rc(int b, int& R, int& C) { const int st = b / 1024, sb = b % 1024, swz = sb ^ (((sb >> 9) & 1) << 5); R = (st >> 1) * 16 + swz / 64; C = (st & 1) * 32 + (swz % 64) / 2; }
__host__ __device__ __forceinline__ int perm32(int rho) { const int n = rho >> 4, i = rho & 15; return 8 * (i >> 2) + 4 * n + (i & 3); }

struct Unit { int pm, pn; };
struct Gemm { const bf16_t* A; const bf16_t* Bt; int M, N, K; };

struct StaticOrder {
    int nM, nN, nwg, G, c;
    __host__ __device__ void init(int M, int N, int G_, int c_) { nM = M / BM; nN = N / BM; nwg = nM * nN; G = G_; c = c_; }
    __host__ __device__ bool next(int i, Unit& u) const {
        const long L = (long)i * G + c; if (L >= nwg) return false;
        int wgid = (int)L; { const int q = nwg / NXCD, r = nwg % NXCD, xcd = wgid % NXCD, off = wgid / NXCD; wgid = (xcd < r ? xcd * (q + 1) : r * (q + 1) + (xcd - r) * q) + off; }
        const int nig = WGM * nN, gid = wgid / nig, fm = gid * WGM, gsz = (nM - fm) < WGM ? (nM - fm) : WGM;
        u.pm = fm + ((wgid % nig) % gsz); u.pn = (wgid % nig) / gsz; return true;
    }
    __device__ __forceinline__ void a_ready(const Unit&) const {}
    __device__ __forceinline__ void done(const Unit&) const {}
};

__device__ __forceinline__ unsigned cvt_pk_bf16(float lo, float hi) { unsigned r; asm volatile("v_cvt_pk_bf16_f32 %0, %1, %2" : "=v"(r) : "v"(lo), "v"(hi)); return r; }
typedef float f32x2 __attribute__((ext_vector_type(2)));
__device__ __forceinline__ float quad_rows_sum(float v) {
    const auto a = __builtin_amdgcn_permlane16_swap(__float_as_uint(v), __float_as_uint(v), false, false); v = __uint_as_float(a[0]) + __uint_as_float(a[1]);
    const auto b = __builtin_amdgcn_permlane32_swap(__float_as_uint(v), __float_as_uint(v), false, false); return __uint_as_float(b[0]) + __uint_as_float(b[1]);
}
__device__ __forceinline__ float row_rstd(const float* ss, int row) {
    const f32x4* p = (const f32x4*)(ss + (size_t)row * 16);
    const f32x4 a = p[0], b = p[1], c = p[2], d = p[3];
    const float s = (((a[0] + a[1]) + (a[2] + a[3])) + ((b[0] + b[1]) + (b[2] + b[3]))) + (((c[0] + c[1]) + (c[2] + c[3])) + ((d[0] + d[1]) + (d[2] + d[3])));
    return 1.0f / sqrtf(s * (1.0f / 1024.0f) + 1e-6f);
}
__device__ __forceinline__ void rows_rstd(const float* ss, int row0, int fq, float (&rs)[8]) {
    f32x4 v[8];
#pragma unroll
    for (int i = 0; i < 8; ++i) v[i] = *(const f32x4*)(ss + (size_t)(row0 + (i >> 2) * HALF + (i & 3) * 16) * 16 + 4 * fq);
#pragma unroll
    for (int i = 0; i < 8; ++i) { float s = (v[i][0] + v[i][1]) + (v[i][2] + v[i][3]); s = quad_rows_sum(s); rs[i] = __builtin_amdgcn_rsqf(s * (1.0f / 1024.0f) + 1e-6f);     }
}
__device__ __forceinline__ size_t tiled_off(int row, int col, int nc) { return ((size_t)(row >> 4) * (nc >> 5) + (col >> 5)) * 512 + (row & 15) * 32 + (col & 31); }
__device__ __forceinline__ float silu_mul(float g, float u) {
    const float e = __builtin_amdgcn_exp2f(g * -1.4426950408889634f);
    return g * __builtin_amdgcn_rcpf(1.0f + e) * u;
}
struct EpiSwiGLU {
    static constexpr bool PERM = true, AFTER_DRAIN = false;
    bf16_t* O; int ldc; const float* ss;
    typedef float f32x2 __attribute__((ext_vector_type(2)));
    static __device__ __forceinline__ unsigned swiglu_pair(f32x2 g, f32x2 u, float rneg, float ir2) {
        const f32x2 tt = g * rneg; f32x2 e; e.x = __builtin_amdgcn_exp2f(tt.x); e.y = __builtin_amdgcn_exp2f(tt.y);
        const f32x2 d = e * ir2 + ir2; f32x2 q; q.x = __builtin_amdgcn_rcpf(d.x); q.y = __builtin_amdgcn_rcpf(d.y);
        const f32x2 o = (g * u) * q; return cvt_pk_bf16(o.x, o.y);
    }
    static constexpr int NPRE = 2;
    __device__ __forceinline__ void prefetch(const Unit& u, PG8_LAS unsigned char* blk, int wid, int lane) const {
#pragma unroll
        for (int j = 0; j < 2; ++j) __builtin_amdgcn_global_load_lds((const unsigned*)((const char*)ss + (size_t)u.pm * 16384 + (wid * 2 + j) * 1024 + lane * 16), (PG8_LAS unsigned*)(blk + (wid * 2 + j) * 1024), 16, 0, 0); }
    __device__ __forceinline__ void operator()(const f32x4 (&acc)[2][2][4][2], const Unit& u, int wr, int wc, int fr, int fq, const PG8_LAS unsigned char* blk) const {
        f32x4 v[8];
#pragma unroll
        for (int i = 0; i < 8; ++i) v[i] = *(const PG8_LAS f32x4*)(blk + (wr * 64 + fr + (i >> 2) * HALF + (i & 3) * 16) * 64 + 16 * fq);
        float rneg[8], ir2[8];
#pragma unroll
        for (int i = 0; i < 8; ++i) { float s = (v[i][0] + v[i][1]) + (v[i][2] + v[i][3]); s = quad_rows_sum(s); ir2[i] = s * (1.0f / 1024.0f) + 1e-6f; rneg[i] = __builtin_amdgcn_rsqf(ir2[i]) * -1.4426950408889634f; }
#pragma unroll
        for (int ai = 0; ai < 2; ++ai)
#pragma unroll
            for (int m = 0; m < 4; ++m) { const float rn = rneg[ai * 4 + m], iq = ir2[ai * 4 + m];
                const f32x4 g0 = acc[ai][0][m][0], g1 = acc[ai][0][m][1], u0 = acc[ai][1][m][0], u1 = acc[ai][1][m][1];
                u32x4 w; w.x = swiglu_pair((f32x2){g0[0], g0[1]}, (f32x2){u0[0], u0[1]}, rn, iq); w.y = swiglu_pair((f32x2){g0[2], g0[3]}, (f32x2){u0[2], u0[3]}, rn, iq);
                w.z = swiglu_pair((f32x2){g1[0], g1[1]}, (f32x2){u1[0], u1[1]}, rn, iq); w.w = swiglu_pair((f32x2){g1[2], g1[3]}, (f32x2){u1[2], u1[3]}, rn, iq);
                *(u32x4*)(O + ((size_t)(u.pm * 16 + wr * 4 + ai * 8 + m) * (ldc >> 5) + (u.pn * 4 + wc)) * 512 + (fr * 32 + 8 * fq)) = w; }
    }
};
struct EpiResid {
    static constexpr bool PERM = true, AFTER_DRAIN = false;
    const float* xin32; bf16_t* xb; float* ss; float alpha;
    static constexpr int NPRE = 0;
    __device__ __forceinline__ void prefetch(const Unit&, PG8_LAS unsigned char*, int, int) const {}
    __device__ __forceinline__ void operator()(const f32x4 (&acc)[2][2][4][2], const Unit& u, int wr, int wc, int fr, int fq, const PG8_LAS unsigned char*) const {
        const int row0 = u.pm * BM + wr * 64 + fr, col0 = u.pn * BM + wc * 32 + 8 * fq;
        auto piece = [&](int ai, int m, int bj, const f32x4& xa, const f32x4& xc) -> float {
            const size_t o2 = ((size_t)(u.pm * 16 + wr * 4 + ai * 8 + m) * 32 + (u.pn * 8 + 4 * bj + wc)) * 512 + (fr * 32 + 8 * fq);
            const f32x4 o0 = xa + acc[ai][bj][m][0] * alpha, o1 = xc + acc[ai][bj][m][1] * alpha;
            u32x4 w; w.x = cvt_pk_bf16(o0[0], o0[1]); w.y = cvt_pk_bf16(o0[2], o0[3]); w.z = cvt_pk_bf16(o1[0], o1[1]); w.w = cvt_pk_bf16(o1[2], o1[3]); *(u32x4*)(xb + o2) = w;
            const float r0 = __uint_as_float(w.x << 16), r1 = __uint_as_float(w.x & 0xffff0000u), r2 = __uint_as_float(w.y << 16), r3 = __uint_as_float(w.y & 0xffff0000u);
            const float r4 = __uint_as_float(w.z << 16), r5 = __uint_as_float(w.z & 0xffff0000u), r6 = __uint_as_float(w.w << 16), r7 = __uint_as_float(w.w & 0xffff0000u);
            return ((r0 * r0 + r1 * r1) + (r2 * r2 + r3 * r3)) + ((r4 * r4 + r5 * r5) + (r6 * r6 + r7 * r7)); };
        if (xin32) {
#pragma unroll
            for (int ai = 0; ai < 2; ++ai) { f32x4 xa[4][2], xc[4][2];
#pragma unroll
                for (int m = 0; m < 4; ++m)
#pragma unroll
                    for (int bj = 0; bj < 2; ++bj) { const size_t o2 = (size_t)(row0 + ai * HALF + m * 16) * 1024 + col0 + bj * HALF; xa[m][bj] = *(const f32x4*)(xin32 + o2); xc[m][bj] = *(const f32x4*)(xin32 + o2 + 4); }
                asm volatile("" ::: "memory");
#pragma unroll
                for (int m = 0; m < 4; ++m) { float sq = piece(ai, m, 0, xa[m][0], xc[m][0]) + piece(ai, m, 1, xa[m][1], xc[m][1]); sq = quad_rows_sum(sq);
                    if (fq == 0) ss[(size_t)(row0 + ai * HALF + m * 16) * 16 + u.pn * 4 + wc] = sq; }
                asm volatile("" ::: "memory"); }
        } else {
            u32x4 xw[2][4][2];
#pragma unroll
            for (int ai = 0; ai < 2; ++ai)
#pragma unroll
                for (int m = 0; m < 4; ++m)
#pragma unroll
                    for (int bj = 0; bj < 2; ++bj) xw[ai][m][bj] = *(const u32x4*)(xb + ((size_t)(u.pm * 16 + wr * 4 + ai * 8 + m) * 32 + (u.pn * 8 + 4 * bj + wc)) * 512 + (fr * 32 + 8 * fq));
            asm volatile("" ::: "memory");
#pragma unroll
            for (int ai = 0; ai < 2; ++ai)
#pragma unroll
                for (int m = 0; m < 4; ++m) { float sq = 0.f;
#pragma unroll
                    for (int bj = 0; bj < 2; ++bj) { const u32x4 x = xw[ai][m][bj];
                        const f32x4 xa = (f32x4){__uint_as_float(x.x << 16), __uint_as_float(x.x & 0xffff0000u), __uint_as_float(x.y << 16), __uint_as_float(x.y & 0xffff0000u)};
                        const f32x4 xc = (f32x4){__uint_as_float(x.z << 16), __uint_as_float(x.z & 0xffff0000u), __uint_as_float(x.w << 16), __uint_as_float(x.w & 0xffff0000u)};
                        sq += piece(ai, m, bj, xa, xc); }
                    sq = quad_rows_sum(sq);
                    if (fq == 0) ss[(size_t)(row0 + ai * HALF + m * 16) * 16 + u.pn * 4 + wc] = sq; }
            asm volatile("" ::: "memory"); }
    }
};
struct EpiProj {
    static constexpr bool PERM = true, AFTER_DRAIN = false;
    bf16_t* P; float* PF; const float* ss; float qscale; _Float16* QIH; _Float16* KIH;
    static constexpr int NPRE = 2;
    __device__ __forceinline__ void prefetch(const Unit& u, PG8_LAS unsigned char* blk, int wid, int lane) const {
#pragma unroll
        for (int j = 0; j < 2; ++j) __builtin_amdgcn_global_load_lds((const unsigned*)((const char*)ss + (size_t)u.pm * 16384 + (wid * 2 + j) * 1024 + lane * 16), (PG8_LAS unsigned*)(blk + (wid * 2 + j) * 1024), 16, 0, 0); }
    __device__ __forceinline__ void operator()(const f32x4 (&acc)[2][2][4][2], const Unit& u, int wr, int wc, int fr, int fq, const PG8_LAS unsigned char* blk) const {
        const int row0 = u.pm * BM + wr * 64 + fr, col0 = u.pn * BM + wc * 32 + 8 * fq;
        const float sc = (u.pn <= 1 || u.pn == 3 || u.pn == 6) ? qscale : 1.0f;
        float rs[8];
#pragma unroll
        for (int i = 0; i < 8; ++i) { const f32x4 v = *(const PG8_LAS f32x4*)(blk + (wr * 64 + fr + (i >> 2) * HALF + (i & 3) * 16) * 64 + 16 * fq);
            float s = (v[0] + v[1]) + (v[2] + v[3]); s = quad_rows_sum(s); rs[i] = __builtin_amdgcn_rsqf(s * (1.0f / 1024.0f) + 1e-6f); }
#pragma unroll
        for (int ai = 0; ai < 2; ++ai)
#pragma unroll
            for (int m = 0; m < 4; ++m) { const int row = row0 + ai * HALF + m * 16; const float r = rs[ai * 4 + m] * sc;
#pragma unroll
                for (int bj = 0; bj < 2; ++bj) { const f32x4 v0 = acc[ai][bj][m][0] * r, v1 = acc[ai][bj][m][1] * r;
                    u32x4 w; w.x = cvt_pk_bf16(v0[0], v0[1]); w.y = cvt_pk_bf16(v0[2], v0[3]); w.z = cvt_pk_bf16(v1[0], v1[1]); w.w = cvt_pk_bf16(v1[2], v1[3]);
                    *(u32x4*)(P + (size_t)row * 2304 + col0 + bj * HALF) = w;
                    if (u.pn >= 7) { const int pc = (col0 - 1792) + bj * HALF;
                        float* pf = PF + (size_t)row * 512 + pc; *(f32x4*)pf = v0; *(f32x4*)(pf + 4) = v1;
                        if (pc >= 128 && pc < 448) { typedef _Float16 h8 __attribute__((ext_vector_type(8))); const float hs = pc < 384 ? 0.125f : 1.0f;
                            h8 o; o[0] = (_Float16)(v0[0] * hs); o[1] = (_Float16)(v0[1] * hs); o[2] = (_Float16)(v0[2] * hs); o[3] = (_Float16)(v0[3] * hs); o[4] = (_Float16)(v1[0] * hs); o[5] = (_Float16)(v1[1] * hs); o[6] = (_Float16)(v1[2] * hs); o[7] = (_Float16)(v1[3] * hs);
                            if (pc < 384) *(h8*)(QIH + (size_t)row * 256 + (pc - 128)) = o;
                            else *(h8*)(KIH + ((((size_t)(row >> 5)) * 8 + ((pc - 384) >> 3)) * 32 + (row & 31)) * 8) = o; } } } }
    }
};
template <class Epi, class Sched, bool ALIGN_EPI = false, bool SP2 = false, bool ATILED = false>
__device__ __forceinline__ void gemm_phase(PG8_LAS unsigned char* lds, const Gemm g, const Sched& S, const Epi& E) {
    int tid_ = threadIdx.x; asm volatile("" : "+v"(tid_));
    float zz_ = 0.f; asm volatile("" : "+v"(zz_));
    const int tid = tid_, wid = __builtin_amdgcn_readfirstlane(tid >> 6), lane = tid & 63, wr = wid >> 2, wc = wid & 3, fr = lane & 15, fq = lane >> 4;
    const int K = g.K, nt = K / BK;
    unsigned voffA, voffB;
    { int R, C; stage_rc(tid * 16, R, C); const int Rb = Epi::PERM ? ((R & ~31) + perm32(R & 31)) : R; voffB = (unsigned)(Rb * K + C) * 2u;
      voffA = ATILED ? (unsigned)((((R >> 4) * (K >> 5) + (C >> 5)) * 512 + (R & 15) * 32 + (C & 31)) * 2) : (unsigned)(R * K + C) * 2u; }
    const size_t qstep = (size_t)64 * K * 2;
    const size_t kstep = (size_t)(BK * 2);
    const size_t kstepA = ATILED ? (size_t)2048 : kstep;
    const size_t hstep = (size_t)HALF * K * 2;
    const size_t tstep = 2 * hstep;
    const unsigned ldsw = (unsigned)wid * 1024u;
    const int aoff = lds_byte(wr * 64 + fr, fq * 8), boff = lds_byte(wc * 32 + fr, fq * 8);
#define PG8_SA(b, h) (((b) * 2 + (h)) * HTB)
#define PG8_SB(b, h) ((4 + (b) * 2 + (h)) * HTB)
#define PG8_STAGE(bufoff, gbase, voff) do { _Pragma("unroll") for (int _i = 0; _i < 2; ++_i) \
        __builtin_amdgcn_global_load_lds((const unsigned*)((const char*)(gbase) + _i * qstep + (voff)), (PG8_LAS unsigned*)(lds + (bufoff) + ldsw + _i * 8192), 16, 0, 0); } while (0)
#define PG8_LDA(dst, b, h) do { _Pragma("unroll") for (int m = 0; m < 4; ++m) _Pragma("unroll") for (int k = 0; k < 2; ++k) dst[m][k] = *(const PG8_LAS bf16x8*)(lds + PG8_SA(b, h) + aoff + m * 2048 + k * 1024); } while (0)
#define PG8_LDB(dst, b, h) do { _Pragma("unroll") for (int n = 0; n < 2; ++n) _Pragma("unroll") for (int k = 0; k < 2; ++k) dst[n][k] = *(const PG8_LAS bf16x8*)(lds + PG8_SB(b, h) + boff + n * 2048 + k * 1024); } while (0)
#define PG8_MMA(ai, bj, At, Bt) do { __builtin_amdgcn_s_setprio(1); _Pragma("unroll") for (int m = 0; m < 4; ++m) _Pragma("unroll") for (int n = 0; n < 2; ++n) _Pragma("unroll") for (int k = 0; k < 2; ++k) \
        acc[ai][bj][m][n] = __builtin_amdgcn_mfma_f32_16x16x32_bf16(Bt[n][k], At[m][k], acc[ai][bj][m][n], 0, 0, 0); __builtin_amdgcn_s_setprio(0); } while (0)
#define PG8_WAIT_V(n) asm volatile("s_waitcnt vmcnt(" #n ")" ::: "memory")
#define PG8_WAIT_L(n) asm volatile("s_waitcnt lgkmcnt(" #n ")" ::: "memory")
#define PG8_BAR __builtin_amdgcn_s_barrier()
#define PG8_SCHED __builtin_amdgcn_sched_barrier(0)
    Unit cur, nxt; int ui = 0;
    if (!S.next(0, cur)) return;
    f32x4 acc[2][2][4][2];
#pragma unroll
    for (int a = 0; a < 2; ++a)
#pragma unroll
        for (int b = 0; b < 2; ++b)
#pragma unroll
            for (int m = 0; m < 4; ++m)
#pragma unroll
                for (int n = 0; n < 2; ++n) acc[a][b][m][n] = (f32x4){zz_, zz_, zz_, zz_};
    bf16x8 At[4][2], B0[2][2], B1[2][2];
    const char* cA = (const char*)g.A + (size_t)cur.pm * tstep; const char* cB = (const char*)g.Bt + (size_t)cur.pn * tstep;
    S.a_ready(cur);
    if constexpr (SP2) {
        PG8_STAGE(PG8_SB(0, 0), cB, voffB); PG8_STAGE(PG8_SB(0, 1), cB + hstep, voffB); PG8_STAGE(PG8_SA(0, 0), cA, voffA); PG8_STAGE(PG8_SA(0, 1), cA + hstep, voffA);
        if (wr == 1) PG8_BAR;
        PG8_WAIT_V(2); PG8_BAR;
        PG8_STAGE(PG8_SB(1, 0), cB + kstep, voffB); PG8_STAGE(PG8_SA(1, 0), cA + kstepA, voffA); PG8_STAGE(PG8_SB(1, 1), cB + hstep + kstep, voffB);
        PG8_WAIT_V(6); PG8_BAR;
    } else {
        PG8_STAGE(PG8_SB(0, 0), cB, voffB); PG8_STAGE(PG8_SA(0, 0), cA, voffA); PG8_STAGE(PG8_SB(0, 1), cB + hstep, voffB); PG8_STAGE(PG8_SA(0, 1), cA + hstep, voffA);
        if (wr == 1) PG8_BAR;
        PG8_WAIT_V(4); PG8_BAR;
        PG8_STAGE(PG8_SB(1, 0), cB + kstep, voffB); PG8_STAGE(PG8_SA(1, 0), cA + kstepA, voffA); PG8_STAGE(PG8_SB(1, 1), cB + hstep + kstep, voffB);
        PG8_WAIT_V(6); PG8_BAR;
    }
    for (;;) {
        const bool has_next = S.next(ui + 1, nxt);
        const char* nA = has_next ? (const char*)g.A + (size_t)nxt.pm * tstep : cA; const char* nB = has_next ? (const char*)g.Bt + (size_t)nxt.pn * tstep : cB;
        for (int t = 0; t < nt; t += 2) {
            const bool last = (t == nt - 2);
            const char* a1 = cA + (size_t)(t + 1) * kstepA;
            const char* a2 = last ? nA : cA + (size_t)(t + 2) * kstepA; const char* b2 = last ? nB : cB + (size_t)(t + 2) * kstep;
            const char* a3 = a2 + kstepA; const char* b3 = b2 + kstep;
            if (last && has_next) S.a_ready(nxt);
            if constexpr (SP2 && Epi::NPRE > 0) { if (last) E.prefetch(cur, lds + STAGE_BYTES, wid, lane); }
            if constexpr (SP2) {
            PG8_LDB(B0, 0, 0); PG8_LDB(B1, 0, 1); PG8_SCHED; PG8_LDA(At, 0, 0); PG8_STAGE(PG8_SA(1, 1), a1 + hstep, voffA);
            if (Epi::NPRE == 2 && last) PG8_WAIT_V(10); else PG8_WAIT_V(8);
            PG8_WAIT_L(0); PG8_BAR; PG8_MMA(0, 0, At, B0); PG8_MMA(0, 1, At, B1); PG8_BAR; PG8_SCHED;
            PG8_LDA(At, 0, 1); PG8_STAGE(PG8_SB(0, 0), b2, voffB); PG8_STAGE(PG8_SB(0, 1), b2 + hstep, voffB); PG8_STAGE(PG8_SA(0, 0), a2, voffA);
            if (Epi::NPRE == 2 && last) PG8_WAIT_V(10); else PG8_WAIT_V(8);
            PG8_WAIT_L(0); PG8_BAR; PG8_MMA(1, 0, At, B0); PG8_MMA(1, 1, At, B1); PG8_BAR; PG8_SCHED;
            PG8_LDB(B0, 1, 0); PG8_LDB(B1, 1, 1); PG8_SCHED; PG8_LDA(At, 1, 0); PG8_STAGE(PG8_SA(0, 1), a2 + hstep, voffA);
            PG8_WAIT_V(8); PG8_WAIT_L(0); PG8_BAR; PG8_MMA(0, 0, At, B0); PG8_MMA(0, 1, At, B1); PG8_BAR; PG8_SCHED;
            PG8_LDA(At, 1, 1); PG8_STAGE(PG8_SB(1, 0), b3, voffB); PG8_STAGE(PG8_SB(1, 1), b3 + hstep, voffB); PG8_STAGE(PG8_SA(1, 0), a3, voffA);
            PG8_WAIT_V(8); PG8_WAIT_L(0); PG8_BAR; PG8_MMA(1, 0, At, B0); PG8_MMA(1, 1, At, B1); PG8_BAR; PG8_SCHED;
            } else {
            PG8_LDB(B0, 0, 0); PG8_SCHED; PG8_LDA(At, 0, 0); PG8_STAGE(PG8_SA(1, 1), a1 + hstep, voffA);
            PG8_WAIT_L(8); PG8_BAR; PG8_WAIT_L(0); PG8_MMA(0, 0, At, B0); PG8_BAR; PG8_SCHED;
            PG8_LDB(B1, 0, 1); PG8_STAGE(PG8_SB(0, 0), b2, voffB);
            PG8_BAR; PG8_WAIT_L(0); PG8_MMA(0, 1, At, B1); PG8_BAR;
            PG8_LDA(At, 0, 1); PG8_STAGE(PG8_SA(0, 0), a2, voffA);
            PG8_BAR; PG8_WAIT_L(0); PG8_MMA(1, 0, At, B0); PG8_BAR; PG8_SCHED;
            PG8_STAGE(PG8_SB(0, 1), b2 + hstep, voffB);
            PG8_WAIT_V(6); PG8_BAR; PG8_MMA(1, 1, At, B1); PG8_BAR;
            PG8_LDB(B0, 1, 0); PG8_SCHED; PG8_LDA(At, 1, 0); PG8_STAGE(PG8_SA(0, 1), a2 + hstep, voffA);
            PG8_WAIT_L(8); PG8_BAR; PG8_WAIT_L(0); PG8_MMA(0, 0, At, B0); PG8_BAR; PG8_SCHED;
            PG8_LDB(B1, 1, 1); PG8_STAGE(PG8_SB(1, 0), b3, voffB);
            PG8_BAR; PG8_WAIT_L(0); PG8_MMA(0, 1, At, B1); PG8_BAR;
            PG8_LDA(At, 1, 1); PG8_STAGE(PG8_SA(1, 0), a3, voffA);
            PG8_BAR; PG8_WAIT_L(0); PG8_MMA(1, 0, At, B0); PG8_BAR; PG8_SCHED;
            PG8_STAGE(PG8_SB(1, 1), b3 + hstep, voffB);
            PG8_WAIT_V(6); PG8_BAR; PG8_MMA(1, 1, At, B1); PG8_BAR;
            }
        }
        if constexpr (ALIGN_EPI) { if (wr == 0) PG8_BAR; }
        if constexpr (!Epi::AFTER_DRAIN) { E(acc, cur, wr, wc, fr, fq, lds + STAGE_BYTES); S.done(cur); }
        if (!has_next) break;
#pragma unroll
        for (int a = 0; a < 2; ++a)
#pragma unroll
            for (int b = 0; b < 2; ++b)
#pragma unroll
                for (int m = 0; m < 4; ++m)
#pragma unroll
                    for (int n = 0; n < 2; ++n) acc[a][b][m][n] = (f32x4){zz_, zz_, zz_, zz_};
        cur = nxt; cA = nA; cB = nB; ++ui;
        if constexpr (ALIGN_EPI) { if (wr == 1) PG8_BAR; }
    }
    PG8_WAIT_V(0);
    if constexpr (!ALIGN_EPI) { if (wr == 0) PG8_BAR; }
    PG8_BAR;
    if constexpr (Epi::AFTER_DRAIN) { E.fused(acc, cur, wr, wc, fr, fq, lds, wid, lane); S.done(cur); }
#undef PG8_SA
#undef PG8_SB
#undef PG8_STAGE
#undef PG8_LDA
#undef PG8_LDB
#undef PG8_MMA
#undef PG8_WAIT_V
#undef PG8_WAIT_L
#undef PG8_BAR
#undef PG8_SCHED
}
}
#define GAS __attribute__((address_space(1)))
#define LAS __attribute__((address_space(3)))
typedef unsigned short bf16;
typedef unsigned v4u __attribute__((ext_vector_type(4)));
typedef float f32x4 __attribute__((ext_vector_type(4)));
typedef short bf16x8 __attribute__((ext_vector_type(8)));
typedef GAS unsigned gu32;
typedef GAS unsigned long long gu64;
#define RLX_AGENT __ATOMIC_RELAXED, __HIP_MEMORY_SCOPE_AGENT
#define LDS_WAIT() asm volatile("s_waitcnt lgkmcnt(0)" ::: "memory")
#define VM_WAIT() asm volatile("s_waitcnt vmcnt(0)" ::: "memory")
__device__ __forceinline__ unsigned long long rt() { return __builtin_amdgcn_s_memrealtime(); }
__device__ __forceinline__ unsigned f2bf(float f) { unsigned u = __builtin_bit_cast(unsigned, f); return (u + 0x7fffu + ((u >> 16) & 1u)) >> 16; }
__device__ __forceinline__ unsigned pk2(float lo, float hi) { return f2bf(lo) | (f2bf(hi) << 16); }

__device__ __forceinline__ int hw_lane() { return (int)__builtin_amdgcn_mbcnt_hi(~0u, __builtin_amdgcn_mbcnt_lo(~0u, 0u)); }
#define hw_tid() (WAVE_IN_WG * 64 + hw_lane())
#define XB_TMO      128
#define XB_XCNT(j)  (256  + 64 * (j))
#define XB_XSUB(j)  (1280 + 64 * (j))
#define XB_XGEN(j)  (2304 + 64 * (j))
#define XB_TOP      3328
#define XB_TOPGEN   3392
#define XCD_BAR_WORDS 3456
#define XB_SPIN_CAP (1u << 18)

__device__ __forceinline__ unsigned xb_ld(unsigned* p)              { return __hip_atomic_load(p, __ATOMIC_RELAXED, __HIP_MEMORY_SCOPE_AGENT); }
__device__ __forceinline__ unsigned xb_add(unsigned* p, unsigned v) { return __hip_atomic_fetch_add(p, v, __ATOMIC_RELAXED, __HIP_MEMORY_SCOPE_AGENT); }
__device__ __forceinline__ unsigned xb_xcc_id() { return (unsigned)__builtin_amdgcn_s_getreg((3 << 11) | 20) & 0xFu; }
#define XB_SPIN(cond, bar) do { unsigned _sp = 0; while (cond) { __builtin_amdgcn_s_sleep(1); \
    if ((++_sp & 255u) == 0u) { if (xb_ld(&(bar)[XB_TMO])) break; if (_sp > XB_SPIN_CAP) { atomicAdd(&(bar)[XB_TMO], 1u); break; } } } } while (0)

struct XcdBarrier {
    unsigned* bar; unsigned x;
    volatile LAS unsigned* st;
};

__device__ __forceinline__ XcdBarrier xcd_barrier_post(unsigned* bar, volatile LAS unsigned* st) {
    XcdBarrier b; b.bar = bar; b.x = xb_xcc_id(); b.st = st;
    if (threadIdx.x == 0) (void)xb_add(&bar[XB_XCNT(b.x)], 1u);
    return b;
}
__device__ __forceinline__ void xcd_barrier_complete(unsigned* bar, unsigned x, unsigned& nloc, unsigned& nx) {
    const unsigned G = gridDim.x * gridDim.y * gridDim.z;
    unsigned sum, cnt, mine, sp = 0u;
    for (;;) {
        sum = 0u; cnt = 0u; mine = 0u;
#pragma unroll
        for (unsigned j = 0; j < 16; ++j) { const unsigned c = xb_ld(&bar[XB_XCNT(j)]); sum += c; cnt += (c > 0u) ? 1u : 0u; mine = (j == x) ? c : mine; }
        if (sum == G) break;
        __builtin_amdgcn_s_sleep(1);
        if ((++sp & 255u) == 0u) { if (xb_ld(&bar[XB_TMO])) break; if (sp > XB_SPIN_CAP) { atomicAdd(&bar[XB_TMO], 1u); break; } }
    }
    nloc = mine > 0u ? mine : 1u; nx = cnt > 0u ? cnt : 1u;
}

__device__ __forceinline__ void xcd_barrier(const XcdBarrier& b) {
    asm volatile("s_waitcnt vmcnt(0)" ::: "memory");
    __syncthreads();
    if (threadIdx.x == 0) {
        unsigned* bar = b.bar;
        __builtin_amdgcn_s_waitcnt(0);
        unsigned nloc = b.st[0], nx = b.st[1];
        if (nloc == 0u) { xcd_barrier_complete(bar, b.x, nloc, nx); b.st[0] = nloc; b.st[1] = nx; }
        const unsigned old = xb_add(&bar[XB_XSUB(b.x)], 1u);
        const unsigned gen = old / nloc;
        if (old + 1u == (gen + 1u) * nloc) {
            __builtin_amdgcn_fence(__ATOMIC_RELEASE, "agent");
            asm volatile("s_waitcnt vmcnt(0)" ::: "memory");
            const unsigned og = xb_add(&bar[XB_TOP], 1u);
            const unsigned tg = og / nx;
            if (og + 1u == (tg + 1u) * nx) xb_add(&bar[XB_TOPGEN], 1u);
            else XB_SPIN(xb_ld(&bar[XB_TOPGEN]) == tg, bar);
            __builtin_amdgcn_fence(__ATOMIC_ACQUIRE, "agent");
            xb_add(&bar[XB_XGEN(b.x)], 1u);
            asm volatile("s_waitcnt vmcnt(0)" ::: "memory");
        } else {
            XB_SPIN(xb_ld(&bar[XB_XGEN(b.x)]) == gen, bar);
            __builtin_amdgcn_fence(__ATOMIC_ACQUIRE, "agent");
            asm volatile("s_waitcnt vmcnt(0)" ::: "memory");
        }
    }
    __syncthreads();
}

constexpr int NWAVES = 8;
constexpr int BATCH = 4, T = 8192, D = 1024, M = BATCH * T, FF = 2816, NGU = 2 * FF, DIN = 2244, NP = 2304, DEPTH = 2;
constexpr int C_QA = 0, C_KA = 512, C_VA = 640, C_QB = 768, C_KB = 1024, C_VB = 1280, C_QC = 1536;
constexpr int PF_CKV = 0, PF_QIDX = 128, PF_KIDX = 384, PF_WIDX = 448;
constexpr float LOG2E = 1.4426950408889634f, QSCALE = 0.125f * LOG2E;
constexpr size_t MiB = 1u << 20;
constexpr size_t WS_CTL = 0, CTL_ZERO_BYTES = 1 * MiB;
constexpr size_t WS_W = 2 * MiB, W_LAYER = 40 * MiB;
constexpr size_t WO_GU1 = 0, WO_D1 = 11 * MiB, WO_IN = 16 * MiB + MiB / 2, WO_OUT = 21 * MiB, WO_GU2 = 23 * MiB, WO_D2 = 34 * MiB;
constexpr size_t WS_SS = 82 * MiB, WS_KMEAN = 84 * MiB, WS_KC = 85 * MiB, WS_VC = 89 * MiB;
constexpr size_t WS_XB = 96 * MiB, WS_ATT = 160 * MiB, WS_PF = 224 * MiB, WS_ACT = 288 * MiB, WS_QIH = 464 * MiB, WS_KIH = 480 * MiB, WS_LISTG = 484 * MiB, WS_END = 500 * MiB;
static_assert(WO_D2 + (size_t)D * FF * 2 <= W_LAYER && WS_W + 2 * W_LAYER <= WS_SS && WS_ACT + (size_t)M * FF * 2 <= WS_QIH, "ws map");
constexpr int CW_BAR = 4096;
constexpr int RING_OFF = 0, RING_BYTES = 131072;
constexpr int LDS_BYTES = 163840;
constexpr int LDSCTL_OFF = LDS_BYTES - 512, MISC_OFF = LDSCTL_OFF + 320;

struct Args {
    const float* x; const float* rbt; const float* n1; const float* g1; const float* u1; const float* d1; const float* nm; const float* win; const float* sinks; const float* kvn; const float* wkv;
    const float* wout; const float* n2; const float* g2; const float* u2; const float* d2; const float* nf; float* out; unsigned char* ws; int ph_lo, ph_hi;
};
typedef const Args __attribute__((address_space(4)))* ArgsCP;
__device__ __forceinline__ Args load_args(ArgsCP p) { Args a; a.x = p->x; a.rbt = p->rbt; a.n1 = p->n1; a.g1 = p->g1; a.u1 = p->u1; a.d1 = p->d1; a.nm = p->nm; a.win = p->win; a.sinks = p->sinks; a.kvn = p->kvn; a.wkv = p->wkv;
    a.wout = p->wout; a.n2 = p->n2; a.g2 = p->g2; a.u2 = p->u2; a.d2 = p->d2; a.nf = p->nf; a.out = p->out; a.ws = p->ws; a.ph_lo = p->ph_lo; a.ph_hi = p->ph_hi; return a; }
#define LOAD_ARGS(A, kp) ArgsCP kp_##A = (kp); asm volatile("" : "+s"(kp_##A)); const Args A = load_args(kp_##A)
struct Frame {
    LAS unsigned char* lds; volatile LAS unsigned* MISC; gu32* ctl;
    int G, wv, vb;
};
struct Ids { int tid, lane, wave; };
__device__ __forceinline__ Ids phase_ids() { int t = threadIdx.x; asm volatile("" : "+v"(t)); Ids I; I.tid = t; I.lane = t & 63; I.wave = __builtin_amdgcn_readfirstlane(t >> 6); return I; }
__device__ __forceinline__ float bf2f(unsigned h) { return __uint_as_float(h << 16); }
__device__ __forceinline__ float wave_sum(float v) {
#pragma unroll
    for (int o = 1; o < 64; o <<= 1) v += __shfl_xor(v, o);
    return v;
}
__device__ __forceinline__ float wave_max(float v) {
#pragma unroll
    for (int o = 1; o < 64; o <<= 1) v = fmaxf(v, __shfl_xor(v, o));
    return v;
}
__device__ __forceinline__ unsigned wave_scan_incl(unsigned x) {
    x += (unsigned)__builtin_amdgcn_update_dpp(0, (int)x, 0x111, 0xf, 0xf, true);
    x += (unsigned)__builtin_amdgcn_update_dpp(0, (int)x, 0x112, 0xf, 0xf, true);
    x += (unsigned)__builtin_amdgcn_update_dpp(0, (int)x, 0x114, 0xf, 0xf, true);
    x += (unsigned)__builtin_amdgcn_update_dpp(0, (int)x, 0x118, 0xf, 0xf, true);
    x += (unsigned)__builtin_amdgcn_update_dpp(0, (int)x, 0x142, 0xa, 0xf, false);
    x += (unsigned)__builtin_amdgcn_update_dpp(0, (int)x, 0x143, 0xc, 0xf, false);
    return x;
}
__device__ __forceinline__ float xor32_max(float v) { const auto r = __builtin_amdgcn_permlane32_swap(__float_as_uint(v), __float_as_uint(v), false, false); return fmaxf(__uint_as_float(r[0]), __uint_as_float(r[1])); }
__device__ __forceinline__ float xor32_sum(float v) { const auto r = __builtin_amdgcn_permlane32_swap(__float_as_uint(v), __float_as_uint(v), false, false); return __uint_as_float(r[0]) + __uint_as_float(r[1]); }
__device__ __forceinline__ float xor16_max(float v) { const auto r = __builtin_amdgcn_permlane16_swap(__float_as_uint(v), __float_as_uint(v), false, false); return fmaxf(__uint_as_float(r[0]), __uint_as_float(r[1])); }
__device__ __forceinline__ float xor16_sum(float v) { const auto r = __builtin_amdgcn_permlane16_swap(__float_as_uint(v), __float_as_uint(v), false, false); return __uint_as_float(r[0]) + __uint_as_float(r[1]); }
__device__ __forceinline__ int t5_bucket(int n) {
    if (n < 16) return n;
    int b = 16;
    b += (n >= 19); b += (n >= 21); b += (n >= 24); b += (n >= 27); b += (n >= 31); b += (n >= 35); b += (n >= 40); b += (n >= 46);
    b += (n >= 52); b += (n >= 59); b += (n >= 67); b += (n >= 77); b += (n >= 87); b += (n >= 99); b += (n >= 113);
    return b;
}
struct TrDesc { const float* W; const float* gain; bf16* WT; int K, N, mode, k0, n0; };
__device__ __forceinline__ TrDesc tr_desc(const float* W, int K, int N, bf16* WT, const float* gain, int mode, int item, int nblk) {
    TrDesc d; d.W = W; d.gain = gain; d.WT = WT; d.K = K; d.N = N; d.mode = mode; d.k0 = 64 * (item / nblk); d.n0 = 32 * (item % nblk); return d; }
__device__ __forceinline__ void tr_load(const TrDesc& d, int lane, float (&w)[32], f32x4 (&g)[2]) {
    const int nn = d.n0 + (lane & 31);
#pragma unroll
    for (int i = 0; i < 32; ++i) { const int kk = 2 * i + (lane >> 5); w[i] = (nn < d.N) ? d.W[(size_t)(d.k0 + kk) * d.N + nn] : 0.f; }
    if (d.gain) { const GAS f32x4* gp = (const GAS f32x4*)(d.gain + d.k0 + 8 * (lane & 7)); g[0] = gp[0]; g[1] = gp[1]; } else { g[0] = (f32x4){1.f, 1.f, 1.f, 1.f}; g[1] = g[0]; }
}
__device__ __forceinline__ void tr_finish(const TrDesc& d, int lane, const float (&w)[32], const f32x4 (&g)[2], LAS float* scr) {
#pragma unroll
    for (int i = 0; i < 32; ++i) { const int kk = 2 * i + (lane >> 5); scr[kk * 33 + (lane & 31)] = w[i]; }
    LDS_WAIT(); asm volatile("" ::: "memory");
    const int c = lane & 7;
    const int orow0 = (d.mode == 0) ? d.n0 : (256 * (d.n0 >> 7) + (d.n0 & 127) + (d.mode == 2 ? 128 : 0));
#pragma unroll
    for (int j = 0; j < 4; ++j) { const int n = (lane >> 3) + 8 * j; const LAS float* s = scr + (8 * c) * 33 + n;
        v4u o; o.x = pk2(s[0 * 33] * g[0][0], s[1 * 33] * g[0][1]); o.y = pk2(s[2 * 33] * g[0][2], s[3 * 33] * g[0][3]); o.z = pk2(s[4 * 33] * g[1][0], s[5 * 33] * g[1][1]); o.w = pk2(s[6 * 33] * g[1][2], s[7 * 33] * g[1][3]);
        *(GAS v4u*)(d.WT + (size_t)(orow0 + n) * d.K + d.k0 + 8 * c) = o; }
    LDS_WAIT(); asm volatile("" ::: "memory");
}
__device__ __forceinline__ void p0_prologue(Frame& F, ArgsCP kp) {
    LOAD_ARGS(A, kp);
    const Ids I = phase_ids();
    LAS float* scr = (LAS float*)(F.lds + RING_OFF + I.wave * 16384);
    const int gw = blockIdx.x * NWAVES + I.wave, NGW = F.G * NWAVES;
    constexpr int I_GU = (D / 64) * (FF / 32), I_DN = (FF / 64) * (D / 32), I_IN = (D / 64) * (NP / 32), I_OUT = (D / 64) * (D / 32);
    constexpr int PER_LAYER = 3 * I_GU + 3 * I_DN + I_IN + I_OUT;
    auto decode = [&](int it) -> TrDesc {
        const int l = it / PER_LAYER; int r = it % PER_LAYER;
        unsigned char* wl = A.ws + WS_W + (size_t)l * W_LAYER;
        if (r < I_GU) return tr_desc(A.g1 + (size_t)l * D * FF, D, FF, (bf16*)(wl + WO_GU1), A.n1 + l * D, 1, r, FF / 32); r -= I_GU;
        if (r < I_GU) return tr_desc(A.u1 + (size_t)l * D * FF, D, FF, (bf16*)(wl + WO_GU1), A.n1 + l * D, 2, r, FF / 32); r -= I_GU;
        if (r < I_DN) return tr_desc(A.d1 + (size_t)l * D * FF, FF, D, (bf16*)(wl + WO_D1), nullptr, 0, r, D / 32); r -= I_DN;
        if (r < I_IN) return tr_desc(A.win + (size_t)l * D * DIN, D, DIN, (bf16*)(wl + WO_IN), A.nm + l * D, 0, r, NP / 32); r -= I_IN;
        if (r < I_OUT) return tr_desc(A.wout + (size_t)l * D * D, D, D, (bf16*)(wl + WO_OUT), nullptr, 0, r, D / 32); r -= I_OUT;
        if (r < I_GU) return tr_desc(A.g2 + (size_t)l * D * FF, D, FF, (bf16*)(wl + WO_GU2), A.n2 + l * D, 1, r, FF / 32); r -= I_GU;
        if (r < I_GU) return tr_desc(A.u2 + (size_t)l * D * FF, D, FF, (bf16*)(wl + WO_GU2), A.n2 + l * D, 2, r, FF / 32); r -= I_GU;
        return tr_desc(A.d2 + (size_t)l * D * FF, FF, D, (bf16*)(wl + WO_D2), nullptr, 0, r, D / 32); };
    { constexpr int TOTAL = DEPTH * PER_LAYER;
      TrDesc dc; float wc[32]; f32x4 gc[2];
      int it = gw;
      if (it < TOTAL) { dc = decode(it); tr_load(dc, I.lane, wc, gc); }
#pragma unroll 1
      while (it < TOTAL) { const int itn = it + NGW; TrDesc dn = dc; float wn[32]; f32x4 gn[2];
          if (itn < TOTAL) { dn = decode(itn); tr_load(dn, I.lane, wn, gn); }
          tr_finish(dc, I.lane, wc, gc, scr);
          dc = dn; gc[0] = gn[0]; gc[1] = gn[1];
#pragma unroll
          for (int i = 0; i < 32; ++i) wc[i] = wn[i];
          it = itn; } }
    bf16* XB = (bf16*)(A.ws + WS_XB); float* SS = (float*)(A.ws + WS_SS);
    for (int blk = gw; blk < M / 16; blk += NGW) { const int fr = I.lane & 15, fq = I.lane >> 4; const size_t row = (size_t)blk * 16 + fr; float s = 0.f;
#pragma unroll 16
        for (int ct = 0; ct < 32; ++ct) { const GAS f32x4* xp = (const GAS f32x4*)(A.x + row * D + 32 * ct + 8 * fq); const f32x4 a = xp[0], b = xp[1];
            s += ((a.x * a.x + a.y * a.y) + (a.z * a.z + a.w * a.w)) + ((b.x * b.x + b.y * b.y) + (b.z * b.z + b.w * b.w));
            v4u o; o.x = pk2(a.x, a.y); o.y = pk2(a.z, a.w); o.z = pk2(b.x, b.y); o.w = pk2(b.z, b.w);
            *(GAS v4u*)(XB + ((size_t)blk * 32 + ct) * 512 + fr * 32 + 8 * fq) = o; }
        s = xor32_sum(xor16_sum(s));
        *(GAS f32x4*)(SS + row * 16 + 4 * fq) = (f32x4){fq == 0 ? s : 0.f, 0.f, 0.f, 0.f}; }
}
__device__ __forceinline__ void prep_phase(Frame& F, ArgsCP kp, int l) {
    LOAD_ARGS(A, kp);
    const Ids I = phase_ids();
    const bf16* P = (const bf16*)(A.ws + WS_ACT); const float* PF = (const float*)(A.ws + WS_PF);
    float* KMEAN = (float*)(A.ws + WS_KMEAN); bf16* KC = (bf16*)(A.ws + WS_KC); bf16* VC = (bf16*)(A.ws + WS_VC);
    { LAS float* red = (LAS float*)(F.lds + 65536);
      for (int it = blockIdx.x; it < BATCH * 32 * 2; it += F.G) { const int b = it >> 6, n = (it >> 1) & 31, ch = it & 1, tg = I.tid >> 4, c8 = I.tid & 15;
        float s[8];
#pragma unroll
        for (int e = 0; e < 8; ++e) s[e] = 0.f;
        const bf16* src = P + ((size_t)(b * T + n * 256 + tg * 8)) * NP + C_KB + 128 * ch + 8 * c8;
#pragma unroll
        for (int i = 0; i < 8; ++i) { const v4u w = *(const GAS v4u*)(src + (size_t)i * NP); s[0] += __uint_as_float(w.x << 16); s[1] += __uint_as_float(w.x & 0xffff0000u); s[2] += __uint_as_float(w.y << 16); s[3] += __uint_as_float(w.y & 0xffff0000u);
            s[4] += __uint_as_float(w.z << 16); s[5] += __uint_as_float(w.z & 0xffff0000u); s[6] += __uint_as_float(w.w << 16); s[7] += __uint_as_float(w.w & 0xffff0000u); }
        __syncthreads();
#pragma unroll
        for (int e = 0; e < 8; ++e) red[tg * 128 + 8 * c8 + e] = s[e];
        __syncthreads();
        if (I.tid < 128) { float t = 0.f; const int col = 128 * ch + I.tid;
#pragma unroll
            for (int g2 = 0; g2 < 32; ++g2) t += red[g2 * 128 + I.tid];
            KMEAN[((size_t)((b * 4 + (col >> 6)) * 32 + n)) * 64 + (col & 63)] = t * (1.0f / 256.0f); } } }
    { const float* Wkv = A.wkv + (size_t)l * 128 * 128; const float* kvg = A.kvn + l * 128;
      LAS unsigned char* WT = F.lds;
      LAS float* GL = (LAS float*)(F.lds + 36864);
      LAS unsigned char* OT = F.lds + 40960 + I.wave * 4608;
      typedef float f32x16k __attribute__((ext_vector_type(16))); typedef float f32x2c __attribute__((ext_vector_type(2))); typedef __bf16 bf16x2c __attribute__((ext_vector_type(2)));
      typedef unsigned u32x2k __attribute__((ext_vector_type(2)));
      __syncthreads();
      for (int i = I.tid; i < 128 * 32; i += NWAVES * 64) { const int k = i >> 5, n4 = (i & 31) * 4; const f32x4 w = *(const GAS f32x4*)(Wkv + k * 128 + n4);
#pragma unroll
          for (int e = 0; e < 4; ++e) *(LAS unsigned short*)(WT + (n4 + e) * 272 + k * 2) = (unsigned short)f2bf(w[e]); }
      if (I.tid < 128) GL[I.tid] = kvg[I.tid];
      __syncthreads();
      const int gw = blockIdx.x * NWAVES + I.wave, NGW = F.G * NWAVES, r32 = I.lane & 31, hi = I.lane >> 5;
      for (int task = gw; task < (M / 32) * 2; task += NGW) { const int tgp = task >> 1, nh = task & 1; const size_t m = (size_t)tgp * 32 + r32;
        f32x4 c[16]; float ssq = 0.f;
#pragma unroll
        for (int s = 0; s < 8; ++s) { const GAS f32x4* cp = (const GAS f32x4*)(PF + m * 512 + PF_CKV + 16 * s + 8 * hi); c[2 * s] = cp[0]; c[2 * s + 1] = cp[1]; }
#pragma unroll
        for (int j = 0; j < 16; ++j) ssq += (c[j].x * c[j].x + c[j].y * c[j].y) + (c[j].z * c[j].z + c[j].w * c[j].w);
        ssq = xor32_sum(ssq);
        const float r = 1.0f / sqrtf(ssq * (1.0f / 128.0f) + 1e-6f);
        bf16x8 bfr[8];
#pragma unroll
        for (int s = 0; s < 8; ++s) { const LAS f32x4* gp = (const LAS f32x4*)(GL + 16 * s + 8 * hi); const f32x4 ga = gp[0], gb = gp[1]; const f32x4 a = c[2 * s] * r * ga, b = c[2 * s + 1] * r * gb;
            v4u w; { const f32x2c p0 = {a.x, a.y}, p1 = {a.z, a.w}, p2 = {b.x, b.y}, p3 = {b.z, b.w};
              w.x = __builtin_bit_cast(unsigned, __builtin_convertvector(p0, bf16x2c)); w.y = __builtin_bit_cast(unsigned, __builtin_convertvector(p1, bf16x2c));
              w.z = __builtin_bit_cast(unsigned, __builtin_convertvector(p2, bf16x2c)); w.w = __builtin_bit_cast(unsigned, __builtin_convertvector(p3, bf16x2c)); }
            bfr[s] = __builtin_bit_cast(bf16x8, w); }
#pragma unroll
        for (int j = 0; j < 2; ++j) { f32x16k acc;
#pragma unroll
            for (int i = 0; i < 16; ++i) acc[i] = 0.f;
#pragma unroll
            for (int s = 0; s < 8; ++s) { const bf16x8 wa = *(const LAS bf16x8*)(WT + (64 * nh + 32 * j + r32) * 272 + (16 * s + 8 * hi) * 2); acc = __builtin_amdgcn_mfma_f32_32x32x16_bf16(wa, bfr[s], acc, 0, 0, 0); }
#pragma unroll
            for (int q4 = 0; q4 < 4; ++q4) { const f32x2c p0 = {acc[4 * q4], acc[4 * q4 + 1]}, p1 = {acc[4 * q4 + 2], acc[4 * q4 + 3]};
                *(LAS u32x2k*)(OT + r32 * 144 + (32 * j + 8 * q4 + 4 * hi) * 2) = (u32x2k){__builtin_bit_cast(unsigned, __builtin_convertvector(p0, bf16x2c)), __builtin_bit_cast(unsigned, __builtin_convertvector(p1, bf16x2c))}; } }
        asm volatile("s_waitcnt lgkmcnt(0)" ::: "memory");
        bf16* dstb = (nh ? VC : KC) + (size_t)tgp * 32 * 64;
#pragma unroll
        for (int it = 0; it < 4; ++it) { const int row = 8 * it + (I.lane >> 3), pc = I.lane & 7; *(GAS v4u*)(dstb + row * 64 + pc * 8) = *(const LAS v4u*)(OT + row * 144 + pc * 16); }
        asm volatile("s_waitcnt lgkmcnt(0)" ::: "memory"); }
      __syncthreads(); }
}
__device__ __forceinline__ void unpack8(const v4u w, float (&f)[8]) {
    f[0] = __uint_as_float(w.x << 16); f[1] = __uint_as_float(w.x & 0xffff0000u); f[2] = __uint_as_float(w.y << 16); f[3] = __uint_as_float(w.y & 0xffff0000u);
    f[4] = __uint_as_float(w.z << 16); f[5] = __uint_as_float(w.z & 0xffff0000u); f[6] = __uint_as_float(w.w << 16); f[7] = __uint_as_float(w.w & 0xffff0000u);
}
__device__ __forceinline__ void key_step(const v4u (&q)[8], const bf16* krow, const bf16* vrow, float bias, float& mrun, float& lsum, float (&o)[64]) {
    float dot = 0.f;
#pragma unroll
    for (int c = 0; c < 8; ++c) { const v4u kw = *(const GAS v4u*)(krow + 8 * c); float kf[8], qf[8]; unpack8(kw, kf); unpack8(q[c], qf);
#pragma unroll
        for (int e = 0; e < 8; ++e) dot += qf[e] * kf[e]; }
    const float sc = dot + bias, mn = fmaxf(mrun, sc), al = __builtin_amdgcn_exp2f(mrun - mn), p = __builtin_amdgcn_exp2f(sc - mn);
    lsum = lsum * al + p; mrun = mn;
#pragma unroll
    for (int c = 0; c < 8; ++c) { const v4u vw = *(const GAS v4u*)(vrow + 8 * c); float vf[8]; unpack8(vw, vf);
#pragma unroll
        for (int e = 0; e < 8; ++e) o[8 * c + e] = o[8 * c + e] * al + p * vf[e]; }
}
__device__ __forceinline__ void store_o(bf16* dst, const float (&o)[64], float inv) {
#pragma unroll
    for (int c = 0; c < 8; ++c) { v4u w; w.x = pk2(o[8 * c] * inv, o[8 * c + 1] * inv); w.y = pk2(o[8 * c + 2] * inv, o[8 * c + 3] * inv); w.z = pk2(o[8 * c + 4] * inv, o[8 * c + 5] * inv); w.w = pk2(o[8 * c + 6] * inv, o[8 * c + 7] * inv);
        *(GAS v4u*)(dst + 8 * c) = w; }
}
__device__ __forceinline__ void swa_naive(Frame& F, ArgsCP kp, int l) {
    LOAD_ARGS(A, kp);
    const Ids I = phase_ids();
    const bf16* P = (const bf16*)(A.ws + WS_ACT); bf16* ATT = (bf16*)(A.ws + WS_ATT);
    LAS float* biasA = (LAS float*)(F.lds);
    __syncthreads();
    for (int i = I.tid; i < 8 * 128; i += NWAVES * 64) { const int h = i >> 7, d = i & 127; biasA[i] = A.rbt[t5_bucket(d) * 16 + h] * LOG2E; }
    __syncthreads();
    for (int item = blockIdx.x * (NWAVES * 64) + I.tid; item < M * 8; item += F.G * NWAVES * 64) {
        const int h = item / M, m = item % M, t = m & (T - 1);
        v4u q[8];
#pragma unroll
        for (int c = 0; c < 8; ++c) q[c] = *(const GAS v4u*)(P + (size_t)m * NP + C_QA + h * 64 + 8 * c);
        float mrun = A.sinks[l * 8 + h] * LOG2E, lsum = 1.0f, o[64];
#pragma unroll
        for (int e = 0; e < 64; ++e) o[e] = 0.f;
        const int nk = (t + 1 < 128) ? (t + 1) : 128;
        for (int i = 0; i < nk; ++i) { const bf16* row = P + (size_t)(m - i) * NP + (h >> 2) * 64; key_step(q, row + C_KA, row + C_VA, biasA[h * 128 + i], mrun, lsum, o); }
        store_o(ATT + (size_t)m * D + h * 64, o, 1.0f / lsum);
    }
}
__device__ __forceinline__ void moba_naive(Frame& F, ArgsCP kp) {
    LOAD_ARGS(A, kp);
    const Ids I = phase_ids();
    const bf16* P = (const bf16*)(A.ws + WS_ACT); bf16* ATT = (bf16*)(A.ws + WS_ATT); const float* KMEAN = (const float*)(A.ws + WS_KMEAN);
    LAS float* biasB = (LAS float*)(F.lds);
    __syncthreads();
    for (int i = I.tid; i < 4 * 128; i += NWAVES * 64) { const int h = i >> 7, d = i & 127; biasB[i] = A.rbt[t5_bucket(d) * 16 + 8 + h] * LOG2E; }
    __syncthreads();
    for (int item = blockIdx.x * (NWAVES * 64) + I.tid; item < M * 4; item += F.G * NWAVES * 64) {
        const int h = item / M, m = item % M, b = m >> 13, t = m & (T - 1), own = t >> 8;
        v4u q[8];
#pragma unroll
        for (int c = 0; c < 8; ++c) q[c] = *(const GAS v4u*)(P + (size_t)m * NP + C_QB + h * 64 + 8 * c);
        float v0 = -INFINITY, v1 = -INFINITY, v2 = -INFINITY; int i0 = -1, i1 = -1, i2 = -1;
        for (int n = 0; n < own; ++n) { const float* km = KMEAN + ((size_t)((b * 4 + h) * 32 + n)) * 64; float g = 0.f;
#pragma unroll
            for (int c = 0; c < 8; ++c) { float qf[8]; unpack8(q[c], qf); const f32x4 ka = *(const GAS f32x4*)(km + 8 * c), kb = *(const GAS f32x4*)(km + 8 * c + 4);
                g += qf[0] * ka.x + qf[1] * ka.y + qf[2] * ka.z + qf[3] * ka.w + qf[4] * kb.x + qf[5] * kb.y + qf[6] * kb.z + qf[7] * kb.w; }
            if (g > v0) { v2 = v1; i2 = i1; v1 = v0; i1 = i0; v0 = g; i0 = n; } else if (g > v1) { v2 = v1; i2 = i1; v1 = g; i1 = n; } else if (g > v2) { v2 = g; i2 = n; } }
        float mrun = -1e30f, lsum = 0.f, o[64];
#pragma unroll
        for (int e = 0; e < 64; ++e) o[e] = 0.f;
        const size_t rb = (size_t)b * T;
        for (int s = own * 256; s <= t; ++s) { const bf16* row = P + (rb + s) * NP + h * 64; const int dd = t - s; key_step(q, row + C_KB, row + C_VB, biasB[h * 128 + (dd < 127 ? dd : 127)], mrun, lsum, o); }
        for (int j = 0; j < 3; ++j) { const int blk = (j == 0) ? i0 : (j == 1) ? i1 : i2; if (blk < 0) continue;
            for (int s = blk * 256; s < blk * 256 + 256; ++s) { const bf16* row = P + (rb + s) * NP + h * 64; const int dd = t - s; key_step(q, row + C_KB, row + C_VB, biasB[h * 128 + (dd < 127 ? dd : 127)], mrun, lsum, o); } }
        store_o(ATT + (size_t)m * D + 512 + h * 64, o, 1.0f / lsum);
    }
}
__device__ __forceinline__ unsigned fkey(float f) { unsigned u = __float_as_uint(f); if (u == 0x80000000u) u = 0u; return (u & 0x80000000u) ? ~u : (u | 0x80000000u); }
__device__ __forceinline__ void dsa_naive(Frame& F, ArgsCP kp) {
    LOAD_ARGS(A, kp);
    const Ids I = phase_ids();
    const bf16* P = (const bf16*)(A.ws + WS_ACT); const float* PF = (const float*)(A.ws + WS_PF); bf16* ATT = (bf16*)(A.ws + WS_ATT);
    const bf16* KC = (const bf16*)(A.ws + WS_KC); const bf16* VC = (const bf16*)(A.ws + WS_VC);
    LAS unsigned* KEYS = (LAS unsigned*)(F.lds);
    LAS float* QI = (LAS float*)(F.lds + 32768);
    LAS float* QC = (LAS float*)(F.lds + 33792);
    LAS float* PB = (LAS float*)(F.lds + 34816);
    LAS unsigned* LIST = (LAS unsigned*)(F.lds + 38912);
    LAS unsigned* HIST = (LAS unsigned*)(F.lds + 39936);
    LAS float* biasC = (LAS float*)(F.lds + 40960);
    LAS float* RED = (LAS float*)(F.lds + 43008);
    LAS unsigned* MS = (LAS unsigned*)(F.lds + 43264);
    LAS float* WQ = (LAS float*)(F.lds + 43328);
    const int tid = I.tid, lane = I.lane, wave = I.wave;
    __syncthreads();
    for (int i = tid; i < 4 * 128; i += NWAVES * 64) { const int h = i >> 7, d = i & 127; biasC[i] = A.rbt[t5_bucket(d) * 16 + 12 + h] * LOG2E; }
    for (int m = blockIdx.x; m < M; m += F.G) {
        const int b = m >> 13, t = m & (T - 1), nk = t + 1; const size_t rb = (size_t)b * T;
        __syncthreads();
        if (tid < 256) QI[tid] = PF[(size_t)m * 512 + PF_QIDX + tid] * 0.125f; else QC[tid - 256] = bf2f(P[(size_t)m * NP + C_QC + (tid - 256)]);
        if (tid < 4) WQ[tid] = PF[(size_t)m * 512 + PF_WIDX + tid] * 0.5f;
        __syncthreads();
        const float w0 = WQ[0], w1 = WQ[1], w2 = WQ[2], w3 = WQ[3];
        for (int s = tid; s < nk; s += NWAVES * 64) {
            const GAS f32x4* kr = (const GAS f32x4*)(PF + (rb + s) * 512 + PF_KIDX); const LAS f32x4* q4 = (const LAS f32x4*)QI;
            float d0 = 0.f, d1 = 0.f, d2 = 0.f, d3 = 0.f;
#pragma unroll 4
            for (int c = 0; c < 16; ++c) { const f32x4 k = kr[c]; const f32x4 a0 = q4[c], a1 = q4[16 + c], a2 = q4[32 + c], a3 = q4[48 + c];
                d0 += k.x * a0.x + k.y * a0.y + k.z * a0.z + k.w * a0.w; d1 += k.x * a1.x + k.y * a1.y + k.z * a1.z + k.w * a1.w;
                d2 += k.x * a2.x + k.y * a2.y + k.z * a2.z + k.w * a2.w; d3 += k.x * a3.x + k.y * a3.y + k.z * a3.z + k.w * a3.w; }
            float sc = fmaxf(d0, 0.f) * w0; sc += fmaxf(d1, 0.f) * w1; sc += fmaxf(d2, 0.f) * w2; sc += fmaxf(d3, 0.f) * w3;
            KEYS[s] = fkey(sc);
        }
        int nsel;
        if (nk <= 256) { if (tid < nk) LIST[tid] = (unsigned)tid; nsel = nk; __syncthreads(); }
        else {
            unsigned prefix = 0u, remaining = 256u;
            for (int pass = 3; pass >= 0; --pass) {
                __syncthreads();
                if (tid < 256) HIST[tid] = 0u;
                __syncthreads();
                const int shift = 8 * pass;
                for (int s = tid; s < nk; s += NWAVES * 64) { const unsigned key = KEYS[s]; const bool match = (pass == 3) || ((key >> (shift + 8)) == prefix);
                    if (match) __hip_atomic_fetch_add(&HIST[(key >> shift) & 255u], 1u, __ATOMIC_RELAXED, __HIP_MEMORY_SCOPE_WORKGROUP); }
                __syncthreads();
                if (wave == 0) {
                    const unsigned c0 = HIST[255 - 4 * lane], c1 = HIST[254 - 4 * lane], c2 = HIST[253 - 4 * lane], c3 = HIST[252 - 4 * lane], tot = c0 + c1 + c2 + c3;
                    unsigned incl = wave_scan_incl(tot);
                    const unsigned excl = incl - tot;
                    if (excl < remaining && remaining <= incl) { unsigned r = remaining - excl, digit;
                        if (r <= c0) digit = 255 - 4 * lane; else { r -= c0; if (r <= c1) digit = 254 - 4 * lane; else { r -= c1; if (r <= c2) digit = 253 - 4 * lane; else { r -= c2; digit = 252 - 4 * lane; } } }
                        MS[0] = (prefix << 8) | digit; MS[1] = r; }
                }
                __syncthreads();
                prefix = MS[0]; remaining = MS[1];
            }
            if (tid == 0) MS[2] = 0u;
            __syncthreads();
            const unsigned tk = prefix, r = remaining, ngt = 256u - r;
            for (int s = tid; s < nk; s += NWAVES * 64) if (KEYS[s] > tk) { const unsigned slot = __hip_atomic_fetch_add(&MS[2], 1u, __ATOMIC_RELAXED, __HIP_MEMORY_SCOPE_WORKGROUP); if (slot < 256u) LIST[slot] = (unsigned)s; }
            if (wave == 0) { unsigned base = 0u;
                for (int s0 = 0; s0 < nk && base < r; s0 += 64) { const int s = s0 + lane; const bool eq = (s < nk) && (KEYS[s] == tk); const unsigned long long mask = __ballot(eq);
                    const unsigned pos = base + (unsigned)__popcll(mask & ((1ull << lane) - 1ull)); if (eq && pos < r) LIST[ngt + pos] = (unsigned)s; base += (unsigned)__popcll(mask); } }
            nsel = 256; __syncthreads();
        }
        { const int h = tid >> 7, j = tid & 127; float sc2[2];
#pragma unroll
            for (int u = 0; u < 2; ++u) { const int jj = j + 128 * u; float sc = -INFINITY;
                if (jj < nsel) { const int s = (int)LIST[jj]; const bf16* krow = KC + (rb + s) * 64; float dot = 0.f;
#pragma unroll
                    for (int c = 0; c < 8; ++c) { const v4u kw = *(const GAS v4u*)(krow + 8 * c); float kf[8]; unpack8(kw, kf); const LAS f32x4* q4 = (const LAS f32x4*)(QC + h * 64 + 8 * c); const f32x4 qa = q4[0], qb = q4[1];
                        dot += kf[0] * qa.x + kf[1] * qa.y + kf[2] * qa.z + kf[3] * qa.w + kf[4] * qb.x + kf[5] * qb.y + kf[6] * qb.z + kf[7] * qb.w; }
                    const int dd = t - s; sc = dot + biasC[h * 128 + (dd < 127 ? dd : 127)]; }
                sc2[u] = sc; }
            const float wm = wave_max(fmaxf(sc2[0], sc2[1])); if (lane == 0) RED[wave] = wm;
            __syncthreads();
            const float hm = fmaxf(RED[2 * h], RED[2 * h + 1]);
            const float p0 = __builtin_amdgcn_exp2f(sc2[0] - hm), p1 = __builtin_amdgcn_exp2f(sc2[1] - hm);
            PB[h * 256 + j] = p0; PB[h * 256 + j + 128] = p1;
            const float ws_ = wave_sum(p0 + p1); if (lane == 0) RED[8 + wave] = ws_;
            __syncthreads();
        }
        if (tid < 256) { const int h = tid >> 6, d = tid & 63; float acc = 0.f;
            for (int jj = 0; jj < nsel; ++jj) acc += PB[h * 256 + jj] * bf2f(VC[(rb + LIST[jj]) * 64 + d]);
            const float lsum = RED[8 + 2 * h] + RED[8 + 2 * h + 1];
            ATT[(size_t)m * D + 768 + h * 64 + d] = (bf16)f2bf(acc / lsum); }
    }
    __syncthreads();
}
__device__ __forceinline__ void final_phase(Frame& F, ArgsCP kp) {
    LOAD_ARGS(A, kp);
    const Ids I = phase_ids();
    const float* SS = (const float*)(A.ws + WS_SS); const bf16* XB = (const bf16*)(A.ws + WS_XB);
    const int gw = blockIdx.x * NWAVES + I.wave, NGW = F.G * NWAVES, fr = I.lane & 15, fq = I.lane >> 4;
    for (int blk = gw; blk < M / 16; blk += NGW) { const size_t row = (size_t)blk * 16 + fr;
        const f32x4 sv = *(const GAS f32x4*)(SS + row * 16 + 4 * fq); float s = (sv.x + sv.y) + (sv.z + sv.w); s = xor32_sum(xor16_sum(s));
        const float r = 1.0f / sqrtf(s * (1.0f / 1024.0f) + 1e-6f);
#pragma unroll 8
        for (int ct = 0; ct < 32; ++ct) { const v4u w = *(const GAS v4u*)(XB + ((size_t)blk * 32 + ct) * 512 + fr * 32 + 8 * fq); float x8[8]; unpack8(w, x8);
            const GAS f32x4* gp = (const GAS f32x4*)(A.nf + 32 * ct + 8 * fq); const f32x4 g0 = gp[0], g1 = gp[1];
            GAS f32x4* op = (GAS f32x4*)(A.out + row * D + 32 * ct + 8 * fq);
            op[0] = (f32x4){x8[0] * r * g0.x, x8[1] * r * g0.y, x8[2] * r * g0.z, x8[3] * r * g0.w}; op[1] = (f32x4){x8[4] * r * g1.x, x8[5] * r * g1.y, x8[6] * r * g1.z, x8[7] * r * g1.w}; }
    }
}
#ifndef DSA_CAND_CAP
#define DSA_CAND_CAP 384u
#endif
__device__ __forceinline__ float sub1(float a, float b) { float r; asm("v_sub_f32 %0, %1, %2" : "=v"(r) : "v"(a), "v"(b)); return r; }
__device__ __forceinline__ int xcd_vblock(int G) { const int bx = blockIdx.x; return (G % 8 == 0) ? (bx % 8) * (G / 8) + bx / 8 : bx; }
typedef float f32x16 __attribute__((ext_vector_type(16)));
typedef short s16x4 __attribute__((ext_vector_type(4)));
typedef short v4i16_t __attribute__((ext_vector_type(4)));
__device__ __forceinline__ int crow(int i, int h) { return (i & 3) + 8 * (i >> 2) + 4 * h; }
typedef float f32x2_t __attribute__((ext_vector_type(2))); typedef __bf16 bf16x2_t __attribute__((ext_vector_type(2)));
__device__ __forceinline__ unsigned cvtpk(float lo, float hi) { const f32x2_t v = {lo, hi}; const bf16x2_t b = __builtin_convertvector(v, bf16x2_t); return __builtin_bit_cast(unsigned, b); }
__device__ __forceinline__ s16x4 vtr(const LAS unsigned char* p) { return __builtin_bit_cast(s16x4, __builtin_amdgcn_ds_read_tr16_b64_v4i16((LAS v4i16_t*)p)); }
__device__ __forceinline__ void glds16(const void* gsrc, unsigned lds_dst) { unsigned keep;
    asm volatile("s_mov_b32 %0, m0\n\ts_mov_b32 m0, %2\n\ts_nop 0\n\tglobal_load_lds_dwordx4 %1, off\n\ts_mov_b32 m0, %0" : "=&s"(keep) : "v"(gsrc), "s"(lds_dst) : "memory"); }
#define ATT_DMA16(gsrc, ldsdst) glds16((const void*)(gsrc), (unsigned)__builtin_amdgcn_readfirstlane((int)(unsigned)(size_t)(ldsdst)))
__device__ __forceinline__ f32x16 qk_tile(const LAS unsigned char* Kimg, int NK, int k0, const bf16x8 (&qf)[4], int r32, int hi, float cinit) {
    f32x16 acc;
#pragma unroll
    for (int i = 0; i < 16; ++i) acc[i] = cinit;
#pragma unroll
    for (int s = 0; s < 4; ++s) { const bf16x8 kf = *(const LAS bf16x8*)(Kimg + ((2 * s + hi) * NK + k0 + r32) * 16); acc = __builtin_amdgcn_mfma_f32_32x32x16_bf16(kf, qf[s], acc, 0, 0, 0); }
    return acc;
}
__device__ __forceinline__ f32x16 qk_tile_t(const LAS unsigned char* Kimg, int NK, int k0, const bf16x8 (&qf)[4], int r32, int hi, const f32x16& init) {
    f32x16 acc;
#pragma unroll
    for (int s = 0; s < 4; ++s) { const bf16x8 kf = *(const LAS bf16x8*)(Kimg + ((2 * s + hi) * NK + k0 + r32) * 16); acc = __builtin_amdgcn_mfma_f32_32x32x16_bf16(kf, qf[s], s == 0 ? init : acc, 0, 0, 0); }
    return acc;
}
__device__ __forceinline__ void softmax_pv(f32x16 sc, const LAS unsigned char* Vimg, int NK, int k0, int lane, float& m, float& l, f32x16& o0, f32x16& o1) {
    float mx = sc[0];
#pragma unroll
    for (int i = 1; i < 16; ++i) mx = fmaxf(mx, sc[i]);
    mx = xor32_max(mx);
    const float mn = fmaxf(m, mx);
    if (__any(mn > m)) { const float al = __builtin_amdgcn_exp2f(m - mn); l *= al; o0 = o0 * al; o1 = o1 * al; m = mn; }
    float rs = 0.f;
#pragma unroll
    for (int i = 0; i < 16; ++i) { sc[i] = __builtin_amdgcn_exp2f(sc[i] - mn); rs += sc[i]; }
    l += rs;
    bf16x8 pf[2];
#pragma unroll
    for (int s = 0; s < 2; ++s) { v4u w; w.x = cvtpk(sc[8 * s], sc[8 * s + 1]); w.y = cvtpk(sc[8 * s + 2], sc[8 * s + 3]); w.z = cvtpk(sc[8 * s + 4], sc[8 * s + 5]); w.w = cvtpk(sc[8 * s + 6], sc[8 * s + 7]); pf[s] = __builtin_bit_cast(bf16x8, w); }
    const int hi = lane >> 5;
    const LAS unsigned char* vb = Vimg + (k0 >> 3) * 512 + (4 * hi + ((lane & 15) >> 2)) * 64 + (16 * ((lane >> 4) & 1) + 4 * (lane & 3)) * 2;
#pragma unroll
    for (int dh = 0; dh < 2; ++dh)
#pragma unroll
        for (int s = 0; s < 2; ++s) { const s16x4 a = vtr(vb + (dh * (NK >> 3) + 2 * s) * 512), b = vtr(vb + (dh * (NK >> 3) + 2 * s + 1) * 512);
            const bf16x8 vf = (bf16x8){a[0], a[1], a[2], a[3], b[0], b[1], b[2], b[3]};
            if (dh == 0) o0 = __builtin_amdgcn_mfma_f32_32x32x16_bf16(vf, pf[s], o0, 0, 0, 0); else o1 = __builtin_amdgcn_mfma_f32_32x32x16_bf16(vf, pf[s], o1, 0, 0, 0); }
}
__device__ __forceinline__ void store_ot(bf16* dst, const f32x16& o0, const f32x16& o1, float inv, int hi) {
    typedef unsigned u32x2v __attribute__((ext_vector_type(2)));
#pragma unroll
    for (int g = 0; g < 4; ++g) { u32x2v w; w.x = cvtpk(o0[4 * g] * inv, o0[4 * g + 1] * inv); w.y = cvtpk(o0[4 * g + 2] * inv, o0[4 * g + 3] * inv); *(GAS u32x2v*)(dst + 8 * g + 4 * hi) = w;
        u32x2v x; x.x = cvtpk(o1[4 * g] * inv, o1[4 * g + 1] * inv); x.y = cvtpk(o1[4 * g + 2] * inv, o1[4 * g + 3] * inv); *(GAS u32x2v*)(dst + 32 + 8 * g + 4 * hi) = x; }
}
template <int NK> __device__ __forceinline__ void stage_kv(const bf16* Kg, const bf16* Vg, int ld, LAS unsigned char* Kimg, LAS unsigned char* Vimg, int wave, int lane) {
#pragma unroll
    for (int p = wave; p < 8 * (NK / 64); p += NWAVES) { const int c = p & 7, g = p >> 3; ATT_DMA16(Kg + (size_t)(64 * g + lane) * ld + 8 * c, Kimg + (c * NK + 64 * g) * 16); }
#pragma unroll
    for (int p = wave; p < 2 * (NK / 16); p += NWAVES) { const int dh = p & 1, kg = p >> 1; ATT_DMA16(Vg + (size_t)(16 * kg + (lane >> 2)) * ld + 32 * dh + 8 * (lane & 3), Vimg + (dh * (NK / 8) + 2 * kg) * 512); }
}
constexpr int DS_UP_MOBA = 131584;
__device__ __forceinline__ void moba_phase(Frame& F, ArgsCP kp) {
    LOAD_ARGS(A, kp);
    const Ids I = phase_ids(); const int tid = I.tid, lane = I.lane, wave = I.wave, r32 = lane & 31, hi = lane >> 5;
    const bf16* P = (const bf16*)(A.ws + WS_ACT); bf16* ATT = (bf16*)(A.ws + WS_ATT); const float* KMEAN = (const float*)(A.ws + WS_KMEAN);
    constexpr int MOBA_BUF0 = 0;
    LAS float* biasB = (LAS float*)(F.lds + DS_UP_MOBA);
    LAS unsigned* selm = (LAS unsigned*)(F.lds + DS_UP_MOBA + 512);
    for (int w = F.vb; w < 256; w += F.G)
        for (int half = 0; half < 2; ++half) {
            const int bh = w >> 4, ob = half ? 31 - (w & 15) : (w & 15), b = bh >> 2, h = bh & 3;
            const size_t rb = (size_t)b * T;
            __syncthreads();
            if (tid < 128) biasB[tid] = A.rbt[t5_bucket(tid) * 16 + 8 + h] * LOG2E;
            if (tid < 256) {
                const bf16* qp = P + (rb + ob * 256 + tid) * NP + C_QB + h * 64; float qf[64];
#pragma unroll
                for (int c = 0; c < 8; ++c) { const v4u qw = *(const GAS v4u*)(qp + 8 * c); float t8[8]; unpack8(qw, t8);
#pragma unroll
                    for (int e = 0; e < 8; ++e) qf[8 * c + e] = t8[e]; }
                float v0 = -INFINITY, v1 = -INFINITY, v2 = -INFINITY; int i0 = -1, i1 = -1, i2 = -1;
                for (int n = 0; n < ob; ++n) { const float* km = KMEAN + ((size_t)(bh * 32 + n)) * 64; float g = 0.f;
#pragma unroll
                    for (int e = 0; e < 64; ++e) g += qf[e] * km[e];
                    if (g > v0) { v2 = v1; i2 = i1; v1 = v0; i1 = i0; v0 = g; i0 = n; } else if (g > v1) { v2 = v1; i2 = i1; v1 = g; i1 = n; } else if (g > v2) { v2 = g; i2 = n; } }
                unsigned msk = 0u; if (i0 >= 0) msk |= 1u << i0; if (i1 >= 0) msk |= 1u << i1; if (i2 >= 0) msk |= 1u << i2;
                selm[tid] = msk; }
            __syncthreads();
            const int qi = wave * 32 + r32, tq = ob * 256 + qi; const unsigned smask = selm[qi];
            bf16x8 qf[4];
#pragma unroll
            for (int s = 0; s < 4; ++s) qf[s] = *(const GAS bf16x8*)(P + (rb + tq) * NP + C_QB + h * 64 + 16 * s + 8 * hi);
            const float b31 = biasB[127];
            float m = -1e30f, l = 0.f; f32x16 o0, o1;
#pragma unroll
            for (int i = 0; i < 16; ++i) { o0[i] = 0.f; o1[i] = 0.f; }
            stage_kv<256>(P + rb * NP + C_KB + h * 64, P + rb * NP + C_VB + h * 64, NP, F.lds + MOBA_BUF0, F.lds + MOBA_BUF0 + 32768, wave, lane);
            for (int j = 0; j <= ob; ++j) {
                asm volatile("s_waitcnt vmcnt(0)" ::: "memory");
                __syncthreads();
                LAS unsigned char* Kimg = F.lds + MOBA_BUF0 + (j & 1) * 65536; LAS unsigned char* Vimg = Kimg + 32768;
                if (j < ob) { LAS unsigned char* Kn = F.lds + MOBA_BUF0 + ((j + 1) & 1) * 65536;
                    stage_kv<256>(P + (rb + (j + 1) * 256) * NP + C_KB + h * 64, P + (rb + (j + 1) * 256) * NP + C_VB + h * 64, NP, Kn, Kn + 32768, wave, lane); }
                const bool own = (j == ob), sel = own || ((smask >> j) & 1u);
                if (!__any(sel)) continue;
                const int ntile = own ? wave + 1 : 8;
                for (int kt = 0; kt < ntile; ++kt) {
                    const int s0 = j * 256 + kt * 32, dmin = (ob * 256 + wave * 32) - (s0 + 31);
                    const bool cb = dmin >= 113;
                    f32x16 sc = qk_tile(Kimg, 256, kt * 32, qf, r32, hi, cb ? b31 : 0.f);
                    if (!cb) {
#pragma unroll
                        for (int i = 0; i < 16; ++i) { const int dd = tq - (s0 + crow(i, hi)); const int dc = dd < 0 ? 0 : (dd > 127 ? 127 : dd); const float v = sc[i] + biasB[dc]; sc[i] = dd < 0 ? -INFINITY : v; } }
                    if (!sel) {
#pragma unroll
                        for (int i = 0; i < 16; ++i) sc[i] = -INFINITY; }
                    softmax_pv(sc, Vimg, 256, kt * 32, lane, m, l, o0, o1);
                }
            }
            l += __shfl_xor(l, 32);
            store_ot(ATT + (rb + tq) * D + 512 + h * 64, o0, o1, 1.0f / l, hi);
        }
    __syncthreads();
}
#ifndef DSADUP
#define DSADUP 0
#endif
typedef _Float16 f16x8 __attribute__((ext_vector_type(8)));
constexpr int HROW = 1028;
constexpr int DS_UP = 131584, DS_LIST = DS_UP, DS_META = DS_LIST + 16384, DS_BIAS = DS_META + 1024, DS_RAD = DS_BIAS + 2048, DS_DUMP = DS_RAD + 4096, DS_END = DS_DUMP + 4096;
static_assert(DS_END <= LDSCTL_OFF && 32 * HROW * 4 <= DS_UP, "DSA LDS map");
enum { MT_THR = 0, MT_R = 1, MT_MODE = 2, MT_LCNT = 3, MT_CCNT = 4, MT_LO = 5, MT_HI = 6 };
enum { MODE_CAND = 0, MODE_TIE = 1, MODE_OVER = 2 };
__device__ __forceinline__ unsigned fkey32(float f) { const unsigned u = __float_as_uint(f); return u ^ ((unsigned)((int)u >> 31) | 0x80000000u); }
__device__ __forceinline__ float relu_bits(float x) { const int xi = __builtin_bit_cast(int, x); return __builtin_bit_cast(float, xi > 0 ? xi : 0); }
constexpr unsigned HB_MB = 4u, HB_SH = 23u - HB_MB, LOB = (127u - 32u) << HB_MB;
__device__ __forceinline__ void hist_bin(unsigned key, unsigned row_b2, unsigned c65535, unsigned& addr, unsigned& inc) {
    const int c = (int)__builtin_amdgcn_ubfe(key, HB_SH, 8u + HB_MB); const int cc = c < (int)LOB ? (int)LOB : (c > (int)LOB + 1023 ? (int)LOB + 1023 : c);
    unsigned a; asm("v_bfe_u32 %0, %1, 1, 12\n\tv_lshl_add_u32 %0, %0, 2, %2" : "=&v"(a) : "v"(cc), "v"(row_b2));
    addr = a + ((key >> 31) << 11);
    const unsigned b = (unsigned)cc & 1u; asm("v_mad_u32_u24 %0, %1, %2, 1" : "=v"(inc) : "v"(b), "s"(c65535));
}
__device__ __forceinline__ void horner_ge(unsigned& x, float v, float thr) { unsigned long long c; asm("v_cmp_ge_f32 %0, %1, %2" : "=s"(c) : "v"(v), "v"(thr)); asm("v_addc_co_u32 %0, vcc, %0, %0, %1" : "+v"(x) : "s"(c) : "vcc"); }
__device__ __forceinline__ f32x16 idx_score_tile(const f16x8 (&kf)[4], const LAS unsigned char* qimg, const float (&w)[4], int r32, int hi) {
    f32x16 sc;
#pragma unroll
    for (int i = 0; i < 16; ++i) sc[i] = 0.f;
#pragma unroll
    for (int h = 0; h < 4; ++h) { f32x16 acc;
#pragma unroll
        for (int i = 0; i < 16; ++i) acc[i] = 0.f;
#pragma unroll
        for (int s = 0; s < 4; ++s) { const f16x8 qf = *(const LAS f16x8*)(qimg + ((h * 8 + 2 * s + hi) * 32 + r32) * 16); acc = __builtin_amdgcn_mfma_f32_32x32x16_f16(kf[s], qf, acc, 0, 0, 0); }
#pragma unroll
        for (int i = 0; i < 16; ++i) sc[i] = __builtin_fmaf(relu_bits(acc[i]), w[h], sc[i]); }
    return sc;
}
__device__ __forceinline__ unsigned wave_umin(unsigned v) {
#define WUM_STEP(ctrl, rm) { const unsigned x_ = (unsigned)__builtin_amdgcn_update_dpp((int)0xffffffffu, (int)v, ctrl, rm, 0xf, false); v = x_ < v ? x_ : v; }
    WUM_STEP(0x111, 0xf) WUM_STEP(0x112, 0xf) WUM_STEP(0x114, 0xf) WUM_STEP(0x118, 0xf) WUM_STEP(0x142, 0xa) WUM_STEP(0x143, 0xc)
#undef WUM_STEP
    return (unsigned)__builtin_amdgcn_readlane((int)v, 63);
}
__device__ __forceinline__ void mask_to_list(const LAS unsigned* mask, LAS unsigned short* lst, LAS unsigned short* dump, int lane) {
    const v4u x = ((const LAS v4u*)mask)[lane]; const unsigned c0 = __popc(x.x), c1 = __popc(x.y), c2 = __popc(x.z), tot = c0 + c1 + c2 + __popc(x.w);
    unsigned incl = wave_scan_incl(tot);
    const unsigned rank0 = incl - tot;
#pragma unroll
    for (int k = 0; k < 4; ++k) { unsigned wv = k == 0 ? x.x : k == 1 ? x.y : k == 2 ? x.z : x.w; unsigned rank = k == 0 ? rank0 : k == 1 ? rank0 + c0 : k == 2 ? rank0 + c0 + c1 : rank0 + c0 + c1 + c2;
        const unsigned kb = (unsigned)((4 * lane + k) * 32);
#pragma unroll
        for (int st = 0; st < 4; ++st) { const bool on = wv != 0u && rank < 256u; const unsigned bpos = (unsigned)__builtin_ctz(wv | 0x80000000u);
            LAS unsigned short* dst = on ? lst + rank : dump; *dst = (unsigned short)(kb + bpos); rank += (wv != 0u) ? 1u : 0u; wv &= wv - 1u; }
        while (wv != 0u) { const unsigned bpos = (unsigned)__ffs((int)wv) - 1u; if (rank < 256u) lst[rank] = (unsigned short)(kb + bpos); ++rank; wv &= wv - 1u; } }
}
__device__ __forceinline__ void mask_to_list(const LAS unsigned* mask, LAS unsigned short* lst, int lane) {
    const v4u x = ((const LAS v4u*)mask)[lane]; const unsigned tot = __popc(x.x) + __popc(x.y) + __popc(x.z) + __popc(x.w);
    unsigned incl = wave_scan_incl(tot);
    unsigned rank = incl - tot;
#pragma unroll
    for (int k = 0; k < 4; ++k) { unsigned wv = k == 0 ? x.x : k == 1 ? x.y : k == 2 ? x.z : x.w;
        while (wv != 0u) { const unsigned bpos = (unsigned)__ffs((int)wv) - 1u; if (rank < 256u) lst[rank] = (unsigned short)((4 * lane + k) * 32 + bpos); ++rank; wv &= wv - 1u; } }
}
__device__ __forceinline__ void dsa_select_wg(const float* PF, int m, LAS unsigned char* scr, LAS unsigned short* lst, int tid, int lane, int wave) {
    LAS unsigned* KEYS = (LAS unsigned*)scr; LAS float* QI = (LAS float*)(scr + 32768); LAS unsigned* HIST = (LAS unsigned*)(scr + 33792); LAS unsigned* MS = (LAS unsigned*)(scr + 34816); LAS float* WQ = (LAS float*)(scr + 34880);
    const int b = m >> 13, t = m & (T - 1), nk = t + 1; const size_t rb = (size_t)b * T;
    __syncthreads();
    if (tid < 256) QI[tid] = PF[(size_t)m * 512 + PF_QIDX + tid] * 0.125f;
    if (tid < 4) WQ[tid] = PF[(size_t)m * 512 + PF_WIDX + tid] * 0.5f;
    __syncthreads();
    const float w0 = WQ[0], w1 = WQ[1], w2 = WQ[2], w3 = WQ[3];
    for (int s = tid; s < nk; s += NWAVES * 64) {
        const GAS f32x4* kr = (const GAS f32x4*)(PF + (rb + s) * 512 + PF_KIDX); const LAS f32x4* q4 = (const LAS f32x4*)QI;
        float d0 = 0.f, d1 = 0.f, d2 = 0.f, d3 = 0.f;
#pragma unroll 4
        for (int c = 0; c < 16; ++c) { const f32x4 k = kr[c]; const f32x4 a0 = q4[c], a1 = q4[16 + c], a2 = q4[32 + c], a3 = q4[48 + c];
            d0 += k.x * a0.x + k.y * a0.y + k.z * a0.z + k.w * a0.w; d1 += k.x * a1.x + k.y * a1.y + k.z * a1.z + k.w * a1.w;
            d2 += k.x * a2.x + k.y * a2.y + k.z * a2.z + k.w * a2.w; d3 += k.x * a3.x + k.y * a3.y + k.z * a3.z + k.w * a3.w; }
        float sc = fmaxf(d0, 0.f) * w0; sc += fmaxf(d1, 0.f) * w1; sc += fmaxf(d2, 0.f) * w2; sc += fmaxf(d3, 0.f) * w3;
        KEYS[s] = fkey(sc);
    }
    unsigned prefix = 0u, remaining = 256u;
    for (int pass = 3; pass >= 0; --pass) {
        __syncthreads();
        if (tid < 256) HIST[tid] = 0u;
        __syncthreads();
        const int shift = 8 * pass;
        for (int s = tid; s < nk; s += NWAVES * 64) { const unsigned key = KEYS[s]; const bool match = (pass == 3) || ((key >> (shift + 8)) == prefix);
            if (match) __hip_atomic_fetch_add(&HIST[(key >> shift) & 255u], 1u, __ATOMIC_RELAXED, __HIP_MEMORY_SCOPE_WORKGROUP); }
        __syncthreads();
        if (wave == 0) {
            const unsigned c0 = HIST[255 - 4 * lane], c1 = HIST[254 - 4 * lane], c2 = HIST[253 - 4 * lane], c3 = HIST[252 - 4 * lane], tot = c0 + c1 + c2 + c3;
            unsigned incl = wave_scan_incl(tot);
            const unsigned excl = incl - tot;
            if (excl < remaining && remaining <= incl) { unsigned r = remaining - excl, digit;
                if (r <= c0) digit = 255 - 4 * lane; else { r -= c0; if (r <= c1) digit = 254 - 4 * lane; else { r -= c1; if (r <= c2) digit = 253 - 4 * lane; else { r -= c2; digit = 252 - 4 * lane; } } }
                MS[0] = (prefix << 8) | digit; MS[1] = r; }
        }
        __syncthreads();
        prefix = MS[0]; remaining = MS[1];
    }
    LAS unsigned* SELM = (LAS unsigned*)(scr + 36864);
    if (tid < 256) SELM[tid] = 0u;
    __syncthreads();
    const unsigned tk = prefix, r = remaining;
    for (int s = tid; s < nk; s += NWAVES * 64) if (KEYS[s] > tk) __hip_atomic_fetch_or(&SELM[s >> 5], 1u << (s & 31), __ATOMIC_RELAXED, __HIP_MEMORY_SCOPE_WORKGROUP);
    if (wave == 0) { unsigned base = 0u;
        for (int s0 = 0; s0 < nk && base < r; s0 += 64) { const int s = s0 + lane; const bool eq = (s < nk) && (KEYS[s] == tk); const unsigned long long mask = __ballot(eq);
            const unsigned pos = base + (unsigned)__popcll(mask & ((1ull << lane) - 1ull)); if (eq && pos < r) __hip_atomic_fetch_or(&SELM[s >> 5], 1u << (s & 31), __ATOMIC_RELAXED, __HIP_MEMORY_SCOPE_WORKGROUP); base += (unsigned)__popcll(mask); } }
    __syncthreads();
    if (wave == 0) mask_to_list(SELM, lst, lane);
    __syncthreads();
}
__device__ __forceinline__ void dsa_phase(Frame& F, ArgsCP kp) {
    LOAD_ARGS(A, kp);
    const Ids I = phase_ids(); const int tid = I.tid, lane = I.lane, wave = I.wave, r32 = lane & 31, hi = lane >> 5;
    const bf16* P = (const bf16*)(A.ws + WS_ACT); const float* PF = (const float*)(A.ws + WS_PF); bf16* ATT = (bf16*)(A.ws + WS_ATT);
    const bf16* KC = (const bf16*)(A.ws + WS_KC); const bf16* VC = (const bf16*)(A.ws + WS_VC);
    const _Float16* QIH = (const _Float16*)(A.ws + WS_QIH); const _Float16* KIH = (const _Float16*)(A.ws + WS_KIH); unsigned short* LISTG = (unsigned short*)(A.ws + WS_LISTG);
    LAS unsigned* HISTW = (LAS unsigned*)F.lds;
    LAS unsigned short* LIST = (LAS unsigned short*)(F.lds + DS_LIST);
    LAS unsigned* META = (LAS unsigned*)(F.lds + DS_META);
    LAS float* biasC = (LAS float*)(F.lds + DS_BIAS);
    LAS unsigned* RAD = (LAS unsigned*)(F.lds + DS_RAD) + wave * 128;
    unsigned zu_ = 0u; asm volatile("" : "+v"(zu_));
    __syncthreads();
    for (int i = tid; i < 4 * 128; i += NWAVES * 64) { const int h = i >> 7, d = i & 127; biasC[i] = A.rbt[t5_bucket(d) * 16 + 12 + h] * LOG2E; }
    for (int w = F.vb; w < 256; w += F.G)
        for (int part = 0; part < 4; ++part) {
            const int b = w >> 6, j = w & 63, qt = (part == 0) ? j : (part == 1) ? 127 - j : (part == 2) ? 128 + j : 255 - j, t0 = qt * 32;
            const size_t rb = (size_t)b * T;
            __syncthreads();
            if (qt >= 8) {
                f16x8 kn[4];
#pragma unroll
                for (int s = 0; s < 4; ++s) kn[s] = *(const GAS f16x8*)(KIH + ((((rb >> 5) + (size_t)(wave <= qt ? wave : qt)) * 8 + 2 * s + hi) * 32 + r32) * 8);
                for (int i = tid; i < 8 * HROW; i += NWAVES * 64) ((LAS v4u*)HISTW)[i] = (v4u){zu_, zu_, zu_, zu_};
                if (tid < 256) META[tid] = 0u;
                const size_t mq = rb + t0 + r32;
                float wq[4];
#pragma unroll
                for (int h = 0; h < 4; ++h) wq[h] = PF[mq * 512 + PF_WIDX + h] * 0.5f;
                const LAS unsigned char* qimg = F.lds + DS_LIST;
#pragma unroll
                for (int pp = 0; pp < 2; ++pp) { const int p = tid + 512 * pp, q = p & 31, c = (p >> 5) & 7, h = p >> 8;
                    *(LAS f16x8*)(F.lds + DS_LIST + p * 16) = *(const GAS f16x8*)(QIH + (rb + t0 + q) * 256 + h * 64 + 8 * c); }
                __syncthreads();
                for (int rep1 = 0; rep1 <= ((DSADUP >> 0) & 1); ++rep1) {
                if (rep1) { __syncthreads(); for (int i = tid; i < 8 * HROW; i += NWAVES * 64) ((LAS v4u*)HISTW)[i] = (v4u){zu_, zu_, zu_, zu_}; __syncthreads(); }
                const unsigned hrow_b = (unsigned)(size_t)(HISTW + r32 * HROW) - 4u * (LOB >> 1); unsigned c65535 = 65535u; asm volatile("" : "+s"(c65535));
                if (rep1) {
#pragma unroll
                    for (int s = 0; s < 4; ++s) kn[s] = *(const GAS f16x8*)(KIH + ((((rb >> 5) + (size_t)(wave <= qt ? wave : qt)) * 8 + 2 * s + hi) * 32 + r32) * 8); }
                for (int kt = wave; kt <= qt; kt += NWAVES) {
                    f16x8 kf[4];
#pragma unroll
                    for (int s = 0; s < 4; ++s) kf[s] = kn[s];
                    { const int ktn = kt + NWAVES <= qt ? kt + NWAVES : qt;
#pragma unroll
                      for (int s = 0; s < 4; ++s) kn[s] = *(const GAS f16x8*)(KIH + ((((rb >> 5) + (size_t)ktn) * 8 + 2 * s + hi) * 32 + r32) * 8); }
#ifdef DSA_XSCORE
                    { const f32x16 sc2 = idx_score_tile(kf, qimg, wq, r32, hi);
#pragma unroll
                      for (int i = 0; i < 16; ++i) asm volatile("" :: "v"(sc2[i]));
#pragma unroll
                      for (int s = 0; s < 4; ++s) asm volatile("" : "+v"(kf[s])); }
#endif
#ifdef DSA_XMFMA
                    {
#pragma unroll
                      for (int h = 0; h < 4; ++h) { f32x16 acc2;
#pragma unroll
                          for (int i = 0; i < 16; ++i) acc2[i] = 0.f;
#pragma unroll
                          for (int s = 0; s < 4; ++s) { const f16x8 qf2 = *(const LAS f16x8*)(qimg + ((h * 8 + 2 * s + hi) * 32 + r32) * 16);
#if DSA_XMFMA == 2
                              acc2 = __builtin_amdgcn_mfma_f32_32x32x16_bf16(__builtin_bit_cast(bf16x8, kf[s]), __builtin_bit_cast(bf16x8, qf2), acc2, 0, 0, 0); }
#else
                              acc2 = __builtin_amdgcn_mfma_f32_32x32x16_f16(kf[s], qf2, acc2, 0, 0, 0); }
#endif

                          asm volatile("" :: "v"(acc2)); }
#pragma unroll
                      for (int s = 0; s < 4; ++s) asm volatile("" : "+v"(kf[s])); }
#endif
                    const f32x16 sc = idx_score_tile(kf, qimg, wq, r32, hi);
                    if (kt != qt) {
#pragma unroll
                        for (int i = 0; i < 16; ++i) { const unsigned key = __float_as_uint(sc[i]);
                            unsigned ha, hv; hist_bin(key, hrow_b, c65535, ha, hv); __hip_atomic_fetch_add((LAS unsigned*)(size_t)ha, hv, __ATOMIC_RELAXED, __HIP_MEMORY_SCOPE_WORKGROUP);
                        }
                    } else {
                        int hl = hi; asm volatile("" : "+v"(hl));
#pragma unroll
                        for (int i = 0; i < 16; ++i) { const unsigned key = __float_as_uint(sc[i]);
                            unsigned ha, hv; hist_bin(key, hrow_b, c65535, ha, hv); if (crow(i, hl) <= r32) __hip_atomic_fetch_add((LAS unsigned*)(size_t)ha, hv, __ATOMIC_RELAXED, __HIP_MEMORY_SCOPE_WORKGROUP); }
                    }
                }
                }
                __syncthreads();
                f16x8 kn2[4];
#pragma unroll
                for (int s = 0; s < 4; ++s) kn2[s] = *(const GAS f16x8*)(KIH + ((((rb >> 5) + (size_t)(wave <= qt ? wave : qt)) * 8 + 2 * s + hi) * 32 + r32) * 8);
#pragma unroll
                for (int qq = 0; qq < 4; ++qq) { const int q = 4 * wave + qq;
                    const int wbase = lane < 32 ? 496 - 16 * lane : 512 + 16 * (lane - 32);
                    const LAS v4u* hw = (const LAS v4u*)(HISTW + q * HROW + wbase);
                    v4u x[4]; unsigned tot = 0u;
#pragma unroll
                    for (int k = 0; k < 4; ++k) { x[k] = hw[k]; tot += (x[k].x & 0xffffu) + (x[k].x >> 16) + (x[k].y & 0xffffu) + (x[k].y >> 16) + (x[k].z & 0xffffu) + (x[k].z >> 16) + (x[k].w & 0xffffu) + (x[k].w >> 16); }
                    unsigned incl = wave_scan_incl(tot);
                    const unsigned excl = incl - tot;
                    if (excl < 256u && 256u <= incl) { unsigned rem = 256u - excl, rb = 0u, cin = 0u; bool found = false;
                        if (lane < 32) {
#pragma unroll
                            for (int k = 15; k >= 0; --k) { const unsigned wv = (k & 3) == 0 ? x[k >> 2].x : (k & 3) == 1 ? x[k >> 2].y : (k & 3) == 2 ? x[k >> 2].z : x[k >> 2].w;
                                unsigned c = wv >> 16; if (!found) { if (rem <= c) { found = true; rb = 2u * (unsigned)(wbase + k) + 1u; cin = c; } else rem -= c; }
                                c = wv & 0xffffu; if (!found) { if (rem <= c) { found = true; rb = 2u * (unsigned)(wbase + k); cin = c; } else rem -= c; } }
                        } else {
#pragma unroll
                            for (int k = 0; k < 16; ++k) { const unsigned wv = (k & 3) == 0 ? x[k >> 2].x : (k & 3) == 1 ? x[k >> 2].y : (k & 3) == 2 ? x[k >> 2].z : x[k >> 2].w;
                                unsigned c = wv & 0xffffu; if (!found) { if (rem <= c) { found = true; rb = 2u * (unsigned)(wbase + k); cin = c; } else rem -= c; }
                                c = wv >> 16; if (!found) { if (rem <= c) { found = true; rb = 2u * (unsigned)(wbase + k) + 1u; cin = c; } else rem -= c; } }
                        }
                        const unsigned c = rb & 1023u; const bool neg = rb >= 1024u, wide = (c == 1023u) || (neg && c == 0u);
                        unsigned blo, bhi;
                        if (!neg) { blo = c == 0u ? 0u : (c + LOB) << HB_SH; bhi = c == 1023u ? 0x7f800000u : (c + 1u + LOB) << HB_SH; }
                        else { blo = 0x80000000u | (c == 1023u ? 0x7f7fffffu : ((c + 1u + LOB) << HB_SH) - 1u); bhi = c == 0u ? 1u : (0x80000000u | (((c + LOB) << HB_SH) - 1u)); }
                        const bool over = (rb != 0u) && (cin > DSA_CAND_CAP || wide);
                        META[MT_THR * 32 + q] = fkey32(__uint_as_float(blo));
                        META[MT_R * 32 + q] = rem; META[MT_MODE * 32 + q] = (rb == 0u) ? MODE_TIE : (over ? MODE_OVER : MODE_CAND); if (over) META[MT_LCNT * 32] = 1u;
                        META[MT_LO * 32 + q] = blo; META[MT_HI * 32 + q] = bhi; }
                }
                __syncthreads();
#pragma unroll 1
                for (int qq = 0; qq < 4; ++qq) { const int q = 4 * wave + qq; ((LAS v4u*)(HISTW + q * HROW + 768))[lane] = (v4u){zu_, zu_, zu_, zu_}; if (META[MT_MODE * 32 + q] == MODE_TIE) ((LAS v4u*)(HISTW + q * HROW))[lane] = (v4u){zu_, zu_, zu_, zu_}; }
                __syncthreads();
                for (int rep2 = 0; rep2 <= ((DSADUP >> 1) & 1); ++rep2) {
                if (rep2) { __syncthreads(); for (int qq = 0; qq < 4; ++qq) { const int q = 4 * wave + qq; ((LAS v4u*)(HISTW + q * HROW + 768))[lane] = (v4u){zu_, zu_, zu_, zu_}; if (META[MT_MODE * 32 + q] == MODE_TIE) ((LAS v4u*)(HISTW + q * HROW))[lane] = (v4u){zu_, zu_, zu_, zu_}; if (lane == 0) META[MT_CCNT * 32 + q] = 0u; } __syncthreads(); }
                { const unsigned mode = META[MT_MODE * 32 + r32]; const float flo = __uint_as_float(META[MT_LO * 32 + r32]), fhi = __uint_as_float(META[MT_HI * 32 + r32]);
                  f16x8 kn[4];
#pragma unroll
                  for (int s = 0; s < 4; ++s) kn[s] = kn2[s];
                  if (rep2) {
#pragma unroll
                      for (int s = 0; s < 4; ++s) kn[s] = *(const GAS f16x8*)(KIH + ((((rb >> 5) + (size_t)(wave <= qt ? wave : qt)) * 8 + 2 * s + hi) * 32 + r32) * 8); }
                  for (int kt = wave; kt <= qt; kt += NWAVES) {
                    f16x8 kf[4];
#pragma unroll
                    for (int s = 0; s < 4; ++s) kf[s] = kn[s];
                    { const int ktn = kt + NWAVES <= qt ? kt + NWAVES : qt;
#pragma unroll
                      for (int s = 0; s < 4; ++s) kn[s] = *(const GAS f16x8*)(KIH + ((((rb >> 5) + (size_t)ktn) * 8 + 2 * s + hi) * 32 + r32) * 8); }
                    const f32x16 sc = idx_score_tile(kf, qimg, wq, r32, hi);
                    const bool diag = (kt == qt);
                    int hl = hi; asm volatile("" : "+v"(hl));
                    unsigned selw = 0u, gew = 0u;
#pragma unroll
                    for (int g = 3; g >= 0; --g) { unsigned ns = 0u, ng = 0u;
#pragma unroll
                        for (int j = 3; j >= 0; --j) { ns = ns + ns + ((sc[4 * g + j] >= fhi) ? 1u : 0u); ng = ng + ng + ((sc[4 * g + j] >= flo) ? 1u : 0u); }
                        selw = (selw << 8) | ns; gew = (gew << 8) | ng; }
                    if (diag) { const int lim = r32 - 4 * hl;
                        const unsigned vm = lim >= 0 ? (0x0F0F0F0Fu & ((2u << lim) - 1u)) : 0u;
                        selw &= vm; gew &= vm; }
                    unsigned eqw = gew & ~selw;
                    selw <<= 4 * hl; { const auto rr_ = __builtin_amdgcn_permlane32_swap(selw, selw, false, false); selw = rr_[0] | rr_[1]; }
                    if (hi == 0) HISTW[r32 * HROW + 768 + kt] = selw;
                    { unsigned tw = eqw << (4 * hl); { const auto rr_ = __builtin_amdgcn_permlane32_swap(tw, tw, false, false); tw = rr_[0] | rr_[1]; } if (mode == MODE_TIE && hi == 0) HISTW[r32 * HROW + kt] = tw; }
                    { unsigned cw = (mode == MODE_CAND) ? eqw : 0u;
                      if (__any(cw != 0u)) {
                        const unsigned pbase = __hip_atomic_fetch_add(&META[MT_CCNT * 32 + r32], (unsigned)__popc(cw), __ATOMIC_RELAXED, __HIP_MEMORY_SCOPE_WORKGROUP);
                        unsigned caddr = (unsigned)(size_t)(HISTW + r32 * HROW) + 8u * pbase; const unsigned kbase = (unsigned)(kt * 32 + 4 * hl);
                        do { const unsigned p = (unsigned)__builtin_ctz(cw | 0x80000000u);
                            const unsigned m0 = 0u - (p & 1u), m1 = 0u - ((p >> 1) & 1u), m2 = 0u - ((p >> 3) & 1u), m3 = 0u - ((p >> 4) & 1u);
                            unsigned a8[8], a4[4], a2[2];
#pragma unroll
                            for (int j = 0; j < 8; ++j) a8[j] = (__float_as_uint(sc[2 * j + 1]) & m0) | (__float_as_uint(sc[2 * j]) & ~m0);
#pragma unroll
                            for (int j = 0; j < 4; ++j) a4[j] = (a8[2 * j + 1] & m1) | (a8[2 * j] & ~m1);
#pragma unroll
                            for (int j = 0; j < 2; ++j) a2[j] = (a4[2 * j + 1] & m2) | (a4[2 * j] & ~m2);
                            const unsigned svb = (a2[1] & m3) | (a2[0] & ~m3);
                            typedef unsigned u32x2w __attribute__((ext_vector_type(2)));
                            if (cw != 0u) { *(LAS u32x2w*)(size_t)caddr = (u32x2w){kbase + p, svb}; caddr += 8u; }
                            cw &= cw - 1u;
                        } while (__any(cw != 0u)); } }
                  } }
                }
                __syncthreads();
                for (int rep3 = 0; rep3 <= ((DSADUP >> 2) & 1); ++rep3)
#pragma unroll 1
                for (int qq = 0; qq < 4; ++qq) { const int q = 4 * wave + qq; const unsigned mode = META[MT_MODE * 32 + q], r = META[MT_R * 32 + q];
                    LAS unsigned* selq = HISTW + q * HROW + 768;
                    if (mode == MODE_TIE) {
                        const v4u x = ((const LAS v4u*)(HISTW + q * HROW))[lane]; const unsigned tot = __popc(x.x) + __popc(x.y) + __popc(x.z) + __popc(x.w);
                        unsigned incl = wave_scan_incl(tot);
                        unsigned rank = incl - tot;
#pragma unroll
                        for (int k = 0; k < 4; ++k) { unsigned wv = k == 0 ? x.x : k == 1 ? x.y : k == 2 ? x.z : x.w, keep = 0u; const unsigned cnt = __popc(wv);
                            if (rank + cnt <= r) keep = wv; else { unsigned n = rank < r ? r - rank : 0u; while (n > 0u && wv != 0u) { const unsigned bb = wv & (0u - wv); keep |= bb; wv ^= bb; --n; } }
                            rank += cnt; if (keep) selq[4 * lane + k] |= keep; }
                    } else if (mode == MODE_CAND) {
                        const unsigned nc = META[MT_CCNT * 32 + q];
                        const LAS unsigned long long* cq = (const LAS unsigned long long*)(HISTW + q * HROW);
#define DSA_CAND_SELECT(NE_) do { \
                        unsigned ck[NE_], ci[NE_]; bool cv[NE_]; const unsigned kbase = META[MT_THR * 32 + q]; \
                        _Pragma("unroll") \
                        for (int e = 0; e < NE_; ++e) { const unsigned id = lane + 64 * e; cv[e] = id < nc; const unsigned long long v = cq[id]; ck[e] = fkey32(__uint_as_float((unsigned)(v >> 32))) - kbase; ci[e] = (unsigned)v & 0xffffu; } \
                        unsigned prefix = 0u, rem = r; \
                        _Pragma("unroll 1") \
                        for (int pass = 0; pass < 3; ++pass) { const int shift = 14 - 7 * pass; \
                            RAD[2 * lane] = 0u; RAD[2 * lane + 1] = 0u; \
                            asm volatile("s_waitcnt lgkmcnt(0)" ::: "memory"); \
                        _Pragma("unroll") \
                            for (int e = 0; e < NE_; ++e) if (cv[e] && (ck[e] >> (shift + 7)) == prefix) __hip_atomic_fetch_add(&RAD[(ck[e] >> shift) & 127u], 1u, __ATOMIC_RELAXED, __HIP_MEMORY_SCOPE_WORKGROUP); \
                            asm volatile("s_waitcnt lgkmcnt(0)" ::: "memory"); \
                            const unsigned c0 = RAD[127 - 2 * lane], c1 = RAD[126 - 2 * lane], tot = c0 + c1; unsigned incl = wave_scan_incl(tot); \
                            const unsigned excl = incl - tot; const bool win = excl < rem && rem <= incl; \
                            unsigned rr = rem - excl, dg = 127u - 2u * lane; if (rr > c0) { rr -= c0; dg = 126u - 2u * lane; } \
                            const unsigned long long wm = __ballot(win); const int wl = wm ? (int)__ffsll((long long)wm) - 1 : 0; \
                            dg = (unsigned)__builtin_amdgcn_readlane((int)dg, wl); rem = (unsigned)__builtin_amdgcn_readlane((int)rr, wl); prefix = (prefix << 7) | dg; \
                            asm volatile("s_waitcnt lgkmcnt(0)" ::: "memory"); } \
                        const unsigned tk = prefix; bool eqv[NE_]; \
                        _Pragma("unroll") \
                        for (int e = 0; e < NE_; ++e) { eqv[e] = cv[e] && ck[e] == tk; if (cv[e] && ck[e] > tk) __hip_atomic_fetch_or(&selq[ci[e] >> 5], 1u << (ci[e] & 31u), __ATOMIC_RELAXED, __HIP_MEMORY_SCOPE_WORKGROUP); } \
                        for (unsigned k = 0; k < rem; ++k) { unsigned best = 0xffffffffu; \
                        _Pragma("unroll") \
                            for (int e = 0; e < NE_; ++e) if (eqv[e] && ci[e] < best) best = ci[e]; \
                            const unsigned wmn = wave_umin(best); \
                        _Pragma("unroll") \
                            for (int e = 0; e < NE_; ++e) if (eqv[e] && ci[e] == wmn) eqv[e] = false; \
                            if (lane == 0 && wmn < 8192u) __hip_atomic_fetch_or(&selq[wmn >> 5], 1u << (wmn & 31u), __ATOMIC_RELAXED, __HIP_MEMORY_SCOPE_WORKGROUP); } \
                        } while (0)
                        if (nc <= 128u) DSA_CAND_SELECT(2); else DSA_CAND_SELECT(6);
#undef DSA_CAND_SELECT
                    }
                    asm volatile("s_waitcnt lgkmcnt(0)" ::: "memory");
                    if (mode != MODE_OVER) mask_to_list(selq, LIST + q * 256, (LAS unsigned short*)RAD + 2 * lane, lane);
                }
                __syncthreads();
#if !defined(X_NOFB)
                if (META[MT_LCNT * 32] != 0u)
#pragma unroll 1
                for (int q = 0; q < 32; ++q) if (META[MT_MODE * 32 + q] == MODE_OVER) dsa_select_wg(PF, (int)(rb + t0 + q), F.lds, LIST + q * 256, tid, lane, wave);
#endif
                __syncthreads();
                { typedef unsigned u32x8v __attribute__((ext_vector_type(8))); const int qcp = tid >> 4, pc = tid & 15;
                  *(GAS u32x8v*)(LISTG + (rb + t0 + qcp) * 256 + 16 * pc) = *(const LAS u32x8v*)(LIST + qcp * 256 + 16 * pc); }
            }
        }
    asm volatile("s_waitcnt vmcnt(0)" ::: "memory");
    __syncthreads();
    __builtin_amdgcn_fence(__ATOMIC_ACQUIRE, "agent");
    asm volatile("s_waitcnt vmcnt(0)" ::: "memory");
    for (int w = F.vb; w < 256; w += F.G)
        for (int part = 0; part < 4; ++part) {
            const int b = w >> 6, j = w & 63, qt = (part == 0) ? j : (part == 1) ? 127 - j : (part == 2) ? 128 + j : 255 - j, t0 = qt * 32;
            const size_t rb = (size_t)b * T;
#if !defined(X_NOATT)
            for (int rep4 = 0; rep4 <= ((DSADUP >> 3) & 1); ++rep4)
            {
              LAS unsigned char* Vimg = F.lds + wave * 16384;
              typedef unsigned u32x2v __attribute__((ext_vector_type(2)));
              const bool all = (qt < 8);
              u32x2v lwn = (u32x2v){0u, 0u};
              if (!all) lwn = *(const GAS u32x2v*)(LISTG + (rb + t0 + 4 * wave) * 256 + 4 * I.lane);
#pragma unroll 1
              for (int qq = 0; qq < 4; ++qq) { const int q = 4 * wave + qq, t = t0 + q, nk = t + 1, nsel = nk < 256 ? nk : 256; const size_t m = rb + t;
                int lane_ = I.lane; asm volatile("" : "+v"(lane_)); const int lane = lane_, col = lane & 15, g = lane >> 4;
                LAS unsigned short* lq = (LAS unsigned short*)(Vimg + 8192);
                LAS float* bqt = (LAS float*)(Vimg + 8192 + 512);
                { int s4[4];
                  if (!all) { const u32x2v lw = lwn; if (qq < 3) lwn = *(const GAS u32x2v*)(LISTG + (m + 1) * 256 + 4 * lane);
                      *(LAS u32x2v*)(lq + 4 * lane) = lw; s4[0] = (int)(lw.x & 0xffffu); s4[1] = (int)(lw.x >> 16); s4[2] = (int)(lw.y & 0xffffu); s4[3] = (int)(lw.y >> 16); }
                  else {
#pragma unroll
                      for (int e = 0; e < 4; ++e) s4[e] = 4 * lane + e; }
#pragma unroll
                  for (int hh = 0; hh < 4; ++hh) { f32x4 bv;
#pragma unroll
                      for (int e = 0; e < 4; ++e) { const int dd = t - s4[e]; const float bb = biasC[hh * 128 + (dd < 0 ? 0 : (dd > 127 ? 127 : dd))]; bv[e] = (4 * lane + e < nsel) ? bb : -INFINITY; }
                      *(LAS f32x4*)(bqt + hh * 256 + 4 * lane) = bv; } }
                bf16x8 qf[2];
#pragma unroll
                for (int ks = 0; ks < 2; ++ks) { qf[ks] = (bf16x8){0, 0, 0, 0, 0, 0, 0, 0}; if (col < 4) qf[ks] = *(const GAS bf16x8*)(P + m * NP + C_QC + col * 64 + 32 * ks + 8 * g); }
                float mr = -1e30f, l = 0.f; f32x4 o[4];
#pragma unroll
                for (int dt = 0; dt < 4; ++dt) o[dt] = (f32x4){0.f, 0.f, 0.f, 0.f};
                const int nch = (nsel + 31) >> 5;
                bf16x8 kA[4], kB[4]; v4u vA[4], vB[4];
#define DSA_LOAD(ci_, KR, VR) do { const int c0_ = 32 * (ci_); unsigned ik_[2], iv_[4]; \
                    if (all) { _Pragma("unroll") for (int T_ = 0; T_ < 2; ++T_) { const int slot = c0_ + 16 * T_ + col; ik_[T_] = slot < nsel ? (unsigned)slot : 0u; } \
                               _Pragma("unroll") for (int ii = 0; ii < 4; ++ii) { const int slot = c0_ + 8 * ii + (lane >> 3); iv_[ii] = slot < nsel ? (unsigned)slot : 0u; } } \
                    else { _Pragma("unroll") for (int T_ = 0; T_ < 2; ++T_) ik_[T_] = lq[c0_ + 16 * T_ + col]; \
                           _Pragma("unroll") for (int ii = 0; ii < 4; ++ii) iv_[ii] = lq[c0_ + 8 * ii + (lane >> 3)]; } \
                    _Pragma("unroll") for (int T_ = 0; T_ < 2; ++T_) { const bf16* kr = KC + (rb + ik_[T_]) * 64 + 8 * g; KR[2 * T_] = *(const GAS bf16x8*)kr; KR[2 * T_ + 1] = *(const GAS bf16x8*)(kr + 32); } \
                    _Pragma("unroll") for (int ii = 0; ii < 4; ++ii) VR[ii] = *(const GAS v4u*)(VC + (rb + iv_[ii]) * 64 + 8 * ((lane & 7) ^ (lane >> 3))); } while (0)
#define DSA_CHUNK(ci_, KR, VR, FIRST) do { LAS unsigned char* vb_ = Vimg + ((ci_) & 1) * 4096; \
                    _Pragma("unroll") for (int ii = 0; ii < 4; ++ii) *(LAS v4u*)(vb_ + ii * 1024 + lane * 16) = VR[ii]; \
                    const f32x4 bq0 = *(const LAS f32x4*)(bqt + (col & 3) * 256 + 32 * (ci_) + 4 * g), bq1 = *(const LAS f32x4*)(bqt + (col & 3) * 256 + 32 * (ci_) + 16 + 4 * g); \
                      \
                    f32x4 s0 = bq0, s1 = bq1; if (!(FIRST)) { _Pragma("unroll") for (int i = 0; i < 4; ++i) { s0[i] = sub1(bq0[i], mr); s1[i] = sub1(bq1[i], mr); } } \
                    _Pragma("unroll") for (int ks = 0; ks < 2; ++ks) { s0 = __builtin_amdgcn_mfma_f32_16x16x32_bf16(KR[ks], qf[ks], s0, 0, 0, 0); s1 = __builtin_amdgcn_mfma_f32_16x16x32_bf16(KR[2 + ks], qf[ks], s1, 0, 0, 0); } \
                    float mx = fmaxf(fmaxf(fmaxf(s0[0], s0[1]), fmaxf(s0[2], s0[3])), fmaxf(fmaxf(s1[0], s1[1]), fmaxf(s1[2], s1[3]))); \
                    mx = xor32_max(xor16_max(mx)); \
                    if (FIRST) { mr = mx; s0 = s0 - mx; s1 = s1 - mx; }                     \
                    else if (__any(mx > 0.f)) { const float d = fmaxf(mx, 0.f), al = __builtin_amdgcn_exp2f(-d); l *= al; _Pragma("unroll") for (int dt = 0; dt < 4; ++dt) o[dt] = o[dt] * al; mr += d; s0 = s0 - d; s1 = s1 - d; } \
                    _Pragma("unroll") for (int i = 0; i < 4; ++i) { s0[i] = __builtin_amdgcn_exp2f(s0[i]); s1[i] = __builtin_amdgcn_exp2f(s1[i]); } \
                    { float rs_ = s0[0]; rs_ += s0[1]; rs_ += s0[2]; rs_ += s0[3]; rs_ += s1[0]; rs_ += s1[1]; rs_ += s1[2]; rs_ += s1[3]; l += rs_; }     \
                    v4u pw; pw.x = cvtpk(s0[0], s0[1]); pw.y = cvtpk(s0[2], s0[3]); pw.z = cvtpk(s1[0], s1[1]); pw.w = cvtpk(s1[2], s1[3]); \
                    const bf16x8 pf = __builtin_bit_cast(bf16x8, pw); \
                    const int vrow = 4 * g + ((lane & 15) >> 2), vr7 = vrow & 7; \
                    s16x4 va_[4], vb2_[4]; \
                    _Pragma("unroll") for (int dt = 0; dt < 4; ++dt) { const LAS unsigned char* vp = vb_ + vrow * 128 + (((2 * dt + ((lane & 3) >> 1)) ^ vr7) << 4) + (lane & 1) * 8; va_[dt] = vtr(vp); vb2_[dt] = vtr(vp + 16 * 128); } \
                    _Pragma("unroll") for (int dt = 0; dt < 4; ++dt) { const bf16x8 vf = (bf16x8){va_[dt][0], va_[dt][1], va_[dt][2], va_[dt][3], vb2_[dt][0], vb2_[dt][1], vb2_[dt][2], vb2_[dt][3]}; \
                        o[dt] = __builtin_amdgcn_mfma_f32_16x16x32_bf16(vf, pf, o[dt], 0, 0, 0); } } while (0)
                DSA_LOAD(0, kA, vA);
                if (nch > 1) DSA_LOAD(1, kB, vB);
                DSA_CHUNK(0, kA, vA, true);
                if (2 < nch) DSA_LOAD(2, kA, vA);
                if (1 < nch) { DSA_CHUNK(1, kB, vB, false); if (3 < nch) DSA_LOAD(3, kB, vB); }
#pragma unroll 1
                for (int ci = 2; ci < nch; ci += 2) {
                    DSA_CHUNK(ci, kA, vA, false);
                    if (ci + 2 < nch) DSA_LOAD(ci + 2, kA, vA);
                    if (ci + 1 < nch) { DSA_CHUNK(ci + 1, kB, vB, false); if (ci + 3 < nch) DSA_LOAD(ci + 3, kB, vB); }
                }
#undef DSA_LOAD
#undef DSA_CHUNK
                l = xor32_sum(xor16_sum(l));
                if (col < 4) { typedef unsigned u32x2v __attribute__((ext_vector_type(2))); const float inv = 1.0f / l; bf16* dst = ATT + m * D + 768 + col * 64 + 4 * g;
#pragma unroll
                    for (int dt = 0; dt < 4; ++dt) { u32x2v w2; w2.x = cvtpk(o[dt][0] * inv, o[dt][1] * inv); w2.y = cvtpk(o[dt][2] * inv, o[dt][3] * inv); *(GAS u32x2v*)(dst + 16 * dt) = w2; } }
              } }
#endif
        }
    __syncthreads();
}
__device__ __forceinline__ void swa_phase(Frame& F, ArgsCP kp, int l) {
    LOAD_ARGS(A, kp);
    const Ids I = phase_ids(); const int tid = I.tid, lane = I.lane, wave = I.wave, r32 = lane & 31, hi = lane >> 5;
    const bf16* P = (const bf16*)(A.ws + WS_ACT); bf16* ATT = (bf16*)(A.ws + WS_ATT);
    LAS unsigned char* Kimg = F.lds; LAS unsigned char* Vimg = F.lds + 32768;
    LAS float* biasA = (LAS float*)(F.lds + 65536);
    __syncthreads();
    for (int i = tid; i < 8 * 416; i += NWAVES * 64) { const int h = i / 416, d = i % 416 - 160; biasA[i] = (d >= 0 && d < 128) ? A.rbt[t5_bucket(d) * 16 + h] * LOG2E : -INFINITY; }
    for (int u = blockIdx.x; u < BATCH * 2 * 64; u += F.G) {
        const int b = u >> 7, kvh = (u >> 6) & 1, qb = u & 63; const size_t rb = (size_t)b * T;
        const int srow0 = qb * 128 - 128;
        __syncthreads();
        { const size_t r0 = rb + (size_t)(srow0 < 0 ? 0 : srow0);
          stage_kv<256>(P + r0 * NP + C_KA + kvh * 64, P + r0 * NP + C_VA + kvh * 64, NP, Kimg, Vimg, wave, lane); }
        asm volatile("s_waitcnt vmcnt(0)" ::: "memory");
        __syncthreads();
        const int g = wave >> 1, hq = kvh * 4 + g; const float sink2 = A.sinks[l * 8 + hq] * LOG2E;
        const int ishift = srow0 < 0 ? 128 : 0;
#pragma unroll 1
        for (int sub = 0; sub < 2; ++sub) {
            const int tl = 64 * (wave & 1) + 32 * sub, tq = qb * 128 + tl + r32;
            bf16x8 qf[4];
#pragma unroll
            for (int s = 0; s < 4; ++s) qf[s] = *(const GAS bf16x8*)(P + (rb + tq) * NP + C_QA + hq * 64 + 16 * s + 8 * hi);
            float m = sink2, lsum = hi == 0 ? 1.0f : 0.f; f32x16 o0, o1;
#pragma unroll
            for (int i = 0; i < 16; ++i) { o0[i] = 0.f; o1[i] = 0.f; }
            const int j0 = (tl >> 5);
#pragma unroll 1
            for (int jt = 0; jt < 5; ++jt) {
                const int s0 = srow0 + 32 * (j0 + jt);
                if (s0 < 0) continue;
                const int k0 = 32 * (j0 + jt) - ishift;
                f32x16 sc;
                { int hl_ = hi; asm volatile("" : "+v"(hl_)); const LAS float* tp_ = biasA + hq * 416 + (160 - 27) + (tq - s0 - 4 * hl_);
                  f32x16 in_;
#pragma unroll
                  for (int i = 0; i < 16; ++i) in_[i] = tp_[27 - ((i & 3) + 8 * (i >> 2))];
                  sc = qk_tile_t(Kimg, 256, k0, qf, r32, hi, in_); }
                softmax_pv(sc, Vimg, 256, k0, lane, m, lsum, o0, o1);
            }
            lsum += __shfl_xor(lsum, 32);
            store_ot(ATT + (rb + tq) * D + hq * 64, o0, o1, 1.0f / lsum, hi);
        }
    }
    __syncthreads();
}
__device__ __forceinline__ void rm_issue32(const bf16* row0, size_t ld, LAS unsigned char* img, int lane) {
    const bf16* src = row0 + (size_t)(lane >> 3) * ld + 8 * ((lane & 7) ^ (lane >> 3));
#pragma unroll
    for (int i = 0; i < 4; ++i) ATT_DMA16(src + (size_t)(8 * i) * ld, img + i * 1024);
}
__device__ __forceinline__ f32x16 qk_tile_rm_t(const LAS unsigned char* img, const bf16x8 (&qf)[4], int r32, int hi, const f32x16& init) {
    f32x16 acc;
#pragma unroll
    for (int s = 0; s < 4; ++s) { const bf16x8 kf = *(const LAS bf16x8*)(img + r32 * 128 + (((2 * s + hi) ^ (r32 & 7)) << 4)); acc = __builtin_amdgcn_mfma_f32_32x32x16_bf16(kf, qf[s], s == 0 ? init : acc, 0, 0, 0); }
    return acc;
}
__device__ __forceinline__ f32x16 qk_tile_rm(const LAS unsigned char* img, const bf16x8 (&qf)[4], int r32, int hi, float cinit) {
    f32x16 acc;
#pragma unroll
    for (int i = 0; i < 16; ++i) acc[i] = cinit;
#pragma unroll
    for (int s = 0; s < 4; ++s) { const bf16x8 kf = *(const LAS bf16x8*)(img + r32 * 128 + (((2 * s + hi) ^ (r32 & 7)) << 4)); acc = __builtin_amdgcn_mfma_f32_32x32x16_bf16(kf, qf[s], acc, 0, 0, 0); }
    return acc;
}
__device__ __forceinline__ void softmax_pv_rm(f32x16 sc, const LAS unsigned char* vimg, int lane, float& m, float& l, f32x16& o0, f32x16& o1) {
    float mx = sc[0];
#pragma unroll
    for (int i = 1; i < 16; ++i) mx = fmaxf(mx, sc[i]);
    mx = xor32_max(mx);
    const float mn = fmaxf(m, mx);
    if (__any(mn > m)) { const float al = __builtin_amdgcn_exp2f(m - mn); l *= al; o0 = o0 * al; o1 = o1 * al; m = mn; }
    float rs = 0.f;
#pragma unroll
    for (int i = 0; i < 16; ++i) { sc[i] = __builtin_amdgcn_exp2f(sc[i] - mn); rs += sc[i]; }
    l += rs;
    bf16x8 pf[2];
#pragma unroll
    for (int s = 0; s < 2; ++s) { v4u w; w.x = cvtpk(sc[8 * s], sc[8 * s + 1]); w.y = cvtpk(sc[8 * s + 2], sc[8 * s + 3]); w.z = cvtpk(sc[8 * s + 4], sc[8 * s + 5]); w.w = cvtpk(sc[8 * s + 6], sc[8 * s + 7]); pf[s] = __builtin_bit_cast(bf16x8, w); }
    const int hi = lane >> 5, rl = 4 * hi + ((lane & 15) >> 2), rh = (lane >> 4) & 1, p = lane & 3;
#pragma unroll
    for (int dh = 0; dh < 2; ++dh) { const LAS unsigned char* vb = vimg + rl * 128 + (((4 * dh + 2 * rh + (p >> 1)) ^ rl) << 4) + (p & 1) * 8;
#pragma unroll
        for (int s = 0; s < 2; ++s) { const s16x4 a = vtr(vb + (16 * s) * 128), b = vtr(vb + (16 * s + 8) * 128);
            const bf16x8 vf = (bf16x8){a[0], a[1], a[2], a[3], b[0], b[1], b[2], b[3]};
            if (dh == 0) o0 = __builtin_amdgcn_mfma_f32_32x32x16_bf16(vf, pf[s], o0, 0, 0, 0); else o1 = __builtin_amdgcn_mfma_f32_32x32x16_bf16(vf, pf[s], o1, 0, 0, 0); } }
}
__device__ __forceinline__ void softmax_pv_rm_pre(f32x16 sc, const LAS unsigned char* vimg, int lane, float& m, float& l, f32x16& o0, f32x16& o1) {
    typedef float f32x2 __attribute__((ext_vector_type(2)));
    float mx = sc[0];
#pragma unroll
    for (int i = 1; i < 16; ++i) mx = fmaxf(mx, sc[i]);
    mx = xor32_max(mx);
    if (__any(mx > 0.f)) { const float d = fmaxf(mx, 0.f), al = __builtin_amdgcn_exp2f(-d); l *= al; o0 = o0 * al; o1 = o1 * al; m += d;
#pragma unroll
        for (int i = 0; i < 16; ++i) sc[i] -= d; }
    float rs = 0.f;
#pragma unroll
    for (int i = 0; i < 16; ++i) { sc[i] = __builtin_amdgcn_exp2f(sc[i]); rs += sc[i]; }
    l += rs;
    bf16x8 pf[2];
#pragma unroll
    for (int s = 0; s < 2; ++s) { v4u w; w.x = cvtpk(sc[8 * s], sc[8 * s + 1]); w.y = cvtpk(sc[8 * s + 2], sc[8 * s + 3]); w.z = cvtpk(sc[8 * s + 4], sc[8 * s + 5]); w.w = cvtpk(sc[8 * s + 6], sc[8 * s + 7]); pf[s] = __builtin_bit_cast(bf16x8, w); }
    const int hi = lane >> 5, rl = 4 * hi + ((lane & 15) >> 2), rh = (lane >> 4) & 1, p = lane & 3;
#pragma unroll
    for (int dh = 0; dh < 2; ++dh) { const LAS unsigned char* vb = vimg + rl * 128 + (((4 * dh + 2 * rh + (p >> 1)) ^ rl) << 4) + (p & 1) * 8;
#pragma unroll
        for (int s = 0; s < 2; ++s) { const s16x4 a = vtr(vb + (16 * s) * 128), b = vtr(vb + (16 * s + 8) * 128);
            const bf16x8 vf = (bf16x8){a[0], a[1], a[2], a[3], b[0], b[1], b[2], b[3]};
            if (dh == 0) o0 = __builtin_amdgcn_mfma_f32_32x32x16_bf16(vf, pf[s], o0, 0, 0, 0); else o1 = __builtin_amdgcn_mfma_f32_32x32x16_bf16(vf, pf[s], o1, 0, 0, 0); } }
}
constexpr int MB_UP = 131584, MB_BIAS = MB_UP, MB_SELM = MB_BIAS + 512, MB_CNT = MB_SELM + 1024, MB_NIT = MB_CNT + 128, MB_ITEMS = MB_NIT + 16, MB_LIST = MB_ITEMS + 512, MB_BT = MB_LIST + 8192, MB_END = MB_BT + 2304;
static_assert(MB_END <= LDSCTL_OFF, "MoBA LDS map");
constexpr int MB_PART_STRIDE = 80;
constexpr size_t MB_PART_WG = (size_t)256 * 4 * 2 * MB_PART_STRIDE;
__device__ __forceinline__ void moba_bucket_phase(Frame& F, ArgsCP kp) {
    LOAD_ARGS(A, kp);
    const Ids I = phase_ids(); const int tid = I.tid, lane = I.lane, wave = I.wave, r32 = lane & 31, hi = lane >> 5;
    const bf16* P = (const bf16*)(A.ws + WS_ACT); bf16* ATT = (bf16*)(A.ws + WS_ATT); const float* KMEAN = (const float*)(A.ws + WS_KMEAN);
    unsigned char* PART = (unsigned char*)A.out + (size_t)blockIdx.x * MB_PART_WG;
    LAS float* biasB = (LAS float*)(F.lds + MB_BIAS); LAS float* biasT = (LAS float*)(F.lds + MB_BT); LAS unsigned* selm = (LAS unsigned*)(F.lds + MB_SELM); LAS unsigned* CNT = (LAS unsigned*)(F.lds + MB_CNT);
    LAS unsigned* NIT = (LAS unsigned*)(F.lds + MB_NIT); LAS unsigned* ITEMS = (LAS unsigned*)(F.lds + MB_ITEMS); LAS unsigned char* LISTJ = F.lds + MB_LIST;
    LAS unsigned char* WB = F.lds + wave * 16384;
    for (int w = F.vb; w < 256; w += F.G)
        for (int half = 0; half < 2; ++half) {
            const int bh = w >> 4, ob = half ? 31 - (w & 15) : (w & 15), b = bh >> 2, h = bh & 3;
            const size_t rb = (size_t)b * T;
            __syncthreads();
            if (tid < 128) biasB[tid] = A.rbt[t5_bucket(tid) * 16 + 8 + h] * LOG2E;
            for (int i = tid; i < 576; i += NWAVES * 64) { const int d = i - 32; biasT[i] = d < 0 ? -INFINITY : A.rbt[t5_bucket(d > 127 ? 127 : d) * 16 + 8 + h] * LOG2E; }
            { LAS float* KM = (LAS float*)(F.lds + 8192); LAS float* GP = (LAS float*)F.lds;
              for (int i = tid; i < ob * 16; i += NWAVES * 64) ((LAS f32x4*)KM)[i] = ((const GAS f32x4*)(KMEAN + (size_t)bh * 32 * 64))[i];
              const int gq = tid & 255, part = tid >> 8;
              const bf16* qp = P + (rb + ob * 256 + gq) * NP + C_QB + h * 64; float qv[64];
#pragma unroll
              for (int c = 0; c < 8; ++c) { const v4u qw = *(const GAS v4u*)(qp + 8 * c); float t8[8]; unpack8(qw, t8);
#pragma unroll
                  for (int e = 0; e < 8; ++e) qv[8 * c + e] = t8[e]; }
              __syncthreads();
              float v0 = -INFINITY, v1 = -INFINITY, v2 = -INFINITY; int i0 = -1, i1 = -1, i2 = -1;
              for (int n = part; n < ob; n += 2) { const LAS f32x4* km = (const LAS f32x4*)(KM + n * 64); float g = 0.f;
#pragma unroll
                  for (int c = 0; c < 16; ++c) { const f32x4 k4 = km[c]; g += qv[4 * c] * k4.x; g += qv[4 * c + 1] * k4.y; g += qv[4 * c + 2] * k4.z; g += qv[4 * c + 3] * k4.w; }
                  if (g > v0) { v2 = v1; i2 = i1; v1 = v0; i1 = i0; v0 = g; i0 = n; } else if (g > v1) { v2 = v1; i2 = i1; v1 = g; i1 = n; } else if (g > v2) { v2 = g; i2 = n; } }
              if (part) { *(LAS f32x4*)(GP + gq * 8) = (f32x4){v0, v1, v2, 0.f}; *(LAS v4u*)(GP + gq * 8 + 4) = (v4u){(unsigned)i0, (unsigned)i1, (unsigned)i2, 0u}; }
              __syncthreads();
              if (!part) { const f32x4 bv = *(const LAS f32x4*)(GP + gq * 8); const v4u bi = *(const LAS v4u*)(GP + gq * 8 + 4);
#pragma unroll
                  for (int e = 0; e < 3; ++e) { const float g = e == 0 ? bv.x : e == 1 ? bv.y : bv.z; const int n = (int)(e == 0 ? bi.x : e == 1 ? bi.y : bi.z);
                      if (g > v0 || (g == v0 && n < i0)) { v2 = v1; i2 = i1; v1 = v0; i1 = i0; v0 = g; i0 = n; } else if (g > v1 || (g == v1 && n < i1)) { v2 = v1; i2 = i1; v1 = g; i1 = n; } else if (g > v2 || (g == v2 && n < i2)) { v2 = g; i2 = n; } }
                  unsigned msk = 0u; if (i0 >= 0) msk |= 1u << i0; if (i1 >= 0) msk |= 1u << i1; if (i2 >= 0) msk |= 1u << i2;
                  selm[gq] = msk; } }
            __syncthreads();
            for (int j = wave; j < ob; j += NWAVES) { unsigned base = 0u;
#pragma unroll
                for (int c = 0; c < 4; ++c) { const int q = 64 * c + lane; const bool bit = (selm[q] >> j) & 1u; const unsigned long long mask = __ballot(bit);
                    if (bit) LISTJ[j * 256 + base + (unsigned)__popcll(mask & ((1ull << lane) - 1ull))] = (unsigned char)q; base += (unsigned)__popcll(mask); }
                if (lane == 0) CNT[j] = base; }
            __syncthreads();
            if (wave == 0) {
                const unsigned ng = (lane < ob) ? ((CNT[lane] + 31u) >> 5) : 0u; unsigned incl = wave_scan_incl(ng);
                const unsigned excl = incl - ng, npast = (unsigned)__builtin_amdgcn_readlane((int)incl, 63);
                for (unsigned g = 0; g < ng; ++g) ITEMS[excl + g] = (unsigned)lane * 8u + g;
                if (lane < 8) ITEMS[npast + lane] = 32u * 8u + (unsigned)(7 - lane);
                if (lane == 63) { NIT[0] = 8u + incl; NIT[1] = 0u; } }
            __syncthreads();
            const int nit = (int)NIT[0]; const float b31 = biasB[127];
#define MB_FETCH(KN, ITN, VALIDN, QIDN, QFN) do { int k_ = 0; if (lane == 0) k_ = (int)__hip_atomic_fetch_add(&NIT[1], 1u, __ATOMIC_RELAXED, __HIP_MEMORY_SCOPE_WORKGROUP); KN = __builtin_amdgcn_readfirstlane(k_); \
                if (KN < nit) { ITN = ITEMS[KN]; const int j_ = (int)(ITN >> 3), g_ = (int)(ITN & 7u); const bool own_ = (j_ == 32); \
                    VALIDN = own_ ? true : ((unsigned)(32 * g_ + r32) < CNT[own_ ? 0 : j_]); QIDN = own_ ? 32 * g_ + r32 : (VALIDN ? (int)LISTJ[(own_ ? 0 : j_) * 256 + 32 * g_ + r32] : 0); \
                    _Pragma("unroll") for (int s = 0; s < 4; ++s) QFN[s] = *(const GAS bf16x8*)(P + (rb + ob * 256 + QIDN) * NP + C_QB + h * 64 + 16 * s + 8 * hi); } } while (0)
            int kn; unsigned itn = 0u; bool validn = false; int qidn = 0; bf16x8 qfn[4];
            MB_FETCH(kn, itn, validn, qidn, qfn);
#pragma unroll 1
            while (kn < nit) {
                const unsigned it = itn; const int j = (int)(it >> 3), g = (int)(it & 7u); const bool own = (j == 32);
                const int jb = own ? ob : j;
                const bool valid = validn; const int qid = qidn;
                const int tq = ob * 256 + qid;
                bf16x8 qf[4];
#pragma unroll
                for (int s = 0; s < 4; ++s) qf[s] = qfn[s];
                const int ntile = own ? g + 1 : 8; const bool cb = !own && (jb + 1 < ob);
                const bf16* Kg = P + (rb + (size_t)jb * 256) * NP + C_KB + h * 64; const bf16* Vg = P + (rb + (size_t)jb * 256) * NP + C_VB + h * 64;
                float m = -1e30f, l = 0.f; f32x16 o0, o1;
#pragma unroll
                for (int i = 0; i < 16; ++i) { o0[i] = 0.f; o1[i] = 0.f; }
                asm volatile("s_waitcnt lgkmcnt(0)" ::: "memory");
                rm_issue32(Kg, NP, WB, lane); rm_issue32(Vg, NP, WB + 4096, lane);
#define MB_TILE(kt_, FIRST) do { \
                    asm volatile("s_waitcnt lgkmcnt(0)" ::: "memory");                    \
                    if ((kt_) + 1 < ntile) { LAS unsigned char* nb = WB + (((kt_) + 1) & 1) * 8192; rm_issue32(Kg + (size_t)((kt_) + 1) * 32 * NP, NP, nb, lane); rm_issue32(Vg + (size_t)((kt_) + 1) * 32 * NP, NP, nb + 4096, lane); \
                        asm volatile("s_waitcnt vmcnt(8)" ::: "memory"); } else { asm volatile("s_waitcnt vmcnt(0)" ::: "memory"); } \
                    if (FIRST) MB_FETCH(kn, itn, validn, qidn, qfn);                      \
                    const LAS unsigned char* kb = WB + ((kt_) & 1) * 8192; \
                    f32x16 sc; \
                    if (!cb) { int hl_ = hi; asm volatile("" : "+v"(hl_)); const LAS float* tp_ = biasT + (32 - 27) + (tq - (jb * 256 + (kt_) * 32) - 4 * hl_);     \
                        f32x16 in_; _Pragma("unroll") for (int i = 0; i < 16; ++i) { const float b_ = tp_[27 - ((i & 3) + 8 * (i >> 2))]; in_[i] = (FIRST) ? b_ : sub1(b_, m); }     \
                        sc = qk_tile_rm_t(kb, qf, r32, hi, in_); } \
                    else sc = qk_tile_rm(kb, qf, r32, hi, b31 - ((FIRST) ? 0.f : m)); \
                    if (FIRST) softmax_pv_rm(sc, kb + 4096, lane, m, l, o0, o1); else softmax_pv_rm_pre(sc, kb + 4096, lane, m, l, o0, o1); } while (0)
                MB_TILE(0, true);
#pragma unroll 1
                for (int kt = 1; kt < ntile; ++kt) MB_TILE(kt, false);
#undef MB_TILE
                if (valid) {
                    const int slot = own ? 3 : __popc(selm[qid] & ((1u << j) - 1u));
                    unsigned char* pp = PART + ((size_t)(slot * 5) * 512 + (size_t)(qid * 2 + hi)) * 16;
                    typedef float f32x2v __attribute__((ext_vector_type(2)));
                    *(GAS f32x2v*)pp = (f32x2v){m, l};
#pragma unroll
                    for (int c = 0; c < 4; ++c) { v4u w4; const f32x16& oo = (c < 2) ? o0 : o1; const int e0 = 8 * (c & 1);
                        w4.x = cvtpk(oo[e0], oo[e0 + 1]); w4.y = cvtpk(oo[e0 + 2], oo[e0 + 3]); w4.z = cvtpk(oo[e0 + 4], oo[e0 + 5]); w4.w = cvtpk(oo[e0 + 6], oo[e0 + 7]); *(GAS v4u*)(pp + (size_t)(c + 1) * 8192) = w4; } }
            }
            asm volatile("s_waitcnt vmcnt(0)" ::: "memory");
            __syncthreads();
            __builtin_amdgcn_fence(__ATOMIC_ACQUIRE, "agent");
            asm volatile("s_waitcnt vmcnt(0)" ::: "memory");
#ifdef MB_XMERGE
            for (int rep_ = 0; rep_ < 2; ++rep_)
#endif
            {
                const int qid = 32 * wave + r32, tq = ob * 256 + qid; const int nsel = __popc(selm[qid]);
                float ms[4], ls[4]; float M = -1e30f;
#pragma unroll
                for (int s = 0; s < 4; ++s) { const bool on = (s == 3) || (s < nsel); typedef float f32x2v __attribute__((ext_vector_type(2)));
                    const unsigned char* pp = PART + ((size_t)(s * 5) * 512 + (size_t)(qid * 2 + hi)) * 16; f32x2v ml = *(const GAS f32x2v*)pp; if (!on) ml = (f32x2v){-1e30f, 0.f};
                    ms[s] = ml.x; ls[s] = ml.y; M = fmaxf(M, ml.x); }
                float lt = 0.f; float acc[32];
#pragma unroll
                for (int e = 0; e < 32; ++e) acc[e] = 0.f;
                v4u pw4[4][4];
#pragma unroll
                for (int s = 0; s < 4; ++s) { const unsigned char* pp = PART + ((size_t)(s * 5) * 512 + (size_t)(qid * 2 + hi)) * 16;
#pragma unroll
                    for (int c = 0; c < 4; ++c) pw4[s][c] = *(const GAS v4u*)(pp + (size_t)(c + 1) * 8192); }
#pragma unroll
                for (int s = 0; s < 4; ++s) { const bool on = (s == 3) || (s < nsel); const float f = on ? __builtin_amdgcn_exp2f(ms[s] - M) : 0.f; lt += ls[s] * f;
#pragma unroll
                    for (int c = 0; c < 4; ++c) { v4u w4 = pw4[s][c]; if (!on) w4 = (v4u){0u, 0u, 0u, 0u}; float t8[8]; unpack8(w4, t8);
#pragma unroll
                        for (int e = 0; e < 8; ++e) acc[8 * c + e] += t8[e] * f; } }
                lt += __shfl_xor(lt, 32); const float inv = 1.0f / lt;
                f32x16 o0, o1;
#pragma unroll
                for (int e = 0; e < 16; ++e) { o0[e] = acc[e]; o1[e] = acc[16 + e]; }
                store_ot(ATT + (rb + tq) * D + 512 + h * 64, o0, o1, inv, hi);
            }
        }
    __syncthreads();
}
constexpr int N_PHASES = 18;
struct LimitOrder : pg8::StaticOrder { int lim; __device__ bool next(int i, pg8::Unit& u) const { if (i >= lim) return false; return pg8::StaticOrder::next(i, u); } };
#ifndef EN_SWA
#define EN_SWA 2
#endif
#ifndef EN_MOBA
#define EN_MOBA 3
#endif
#ifndef EN_DSA
#define EN_DSA 2
#endif
#ifndef DUP
#define DUP 0
#endif
#ifndef GEMM_SP2
#define GEMM_SP2 true
#endif
#ifndef RESID_ALIGN
#define RESID_ALIGN true
#endif
#ifndef PHMASK
#define PHMASK 0x3ff
#endif
__global__ void __launch_bounds__(NWAVES * 64, 2) mega_fwd(Args args_unused) {
    extern __shared__ __attribute__((aligned(16))) unsigned char lds[];
    const ArgsCP kp = (ArgsCP)__builtin_amdgcn_kernarg_segment_ptr();
    Frame F;
    F.lds = (LAS unsigned char*)lds; F.MISC = (volatile LAS unsigned*)(F.lds + MISC_OFF);
    F.G = gridDim.x; F.wv = 0; { const int bx = blockIdx.x; F.vb = (F.G % 8 == 0) ? (bx % 8) * (F.G / 8) + bx / 8 : bx; }
    for (int u = threadIdx.x; u < 512 / 4; u += NWAVES * 64) ((LAS unsigned*)(F.lds + LDSCTL_OFF))[u] = 0u;
    __syncthreads();
    const int lo = kp->ph_lo, hi = kp->ph_hi;
    const bool multi = (hi - lo) > 1;
    { unsigned char* ws0 = kp->ws; F.ctl = (gu32*)(ws0 + WS_CTL); }
    XcdBarrier bar; bar.bar = (unsigned*)(F.ctl + CW_BAR); bar.x = 0; bar.st = nullptr;
    if (multi) bar = xcd_barrier_post((unsigned*)(F.ctl + CW_BAR), F.MISC + 8);
#define IN(k) (lo <= (k) && (k) < hi)
#define SEAM(k) do { if (IN(k) && IN((k) + 1)) { XcdBarrier b2_ = bar; asm volatile("" : "+s"(b2_.bar)); xcd_barrier(b2_); if ((DUP >> 12) & 1) xcd_barrier(b2_); } } while (0)
#define WSP(type, name, off) type* name = (type*)(A.ws + (off))
    if (((PHMASK >> 8) & 1) && IN(0)) { p0_prologue(F, kp); if ((DUP >> 8) & 1) { __syncthreads(); p0_prologue(F, kp); } }
    SEAM(0);
    for (int l = 0; l < DEPTH; ++l) {
        const int pb = 1 + 8 * l;
        int bx_l = (int)blockIdx.x; asm volatile("" : "+s"(bx_l));
        int lo_l = lo, hi_l = hi; asm volatile("" : "+s"(lo_l), "+s"(hi_l));
#undef IN
#define IN(k) (lo_l <= (k) && (k) < hi_l)
        if (((PHMASK >> 0) & 1) && IN(pb + 0)) { LOAD_ARGS(A, kp); WSP(bf16, XB, WS_XB); WSP(float, SS, WS_SS); WSP(bf16, ACT, WS_ACT); const bf16* Wt = (const bf16*)(A.ws + WS_W + (size_t)l * W_LAYER + WO_GU1);
            pg8::Gemm g{XB, Wt, M, NGU, D}; pg8::StaticOrder S; S.init(M, NGU, F.G, bx_l);
            pg8::EpiSwiGLU E{ACT, FF, SS}; pg8::gemm_phase<pg8::EpiSwiGLU, pg8::StaticOrder, true, GEMM_SP2, true>(F.lds + RING_OFF, g, S, E);
            if ((DUP >> 0) & 1) pg8::gemm_phase<pg8::EpiSwiGLU, pg8::StaticOrder, true, GEMM_SP2, true>(F.lds + RING_OFF, g, S, E); }
        SEAM(pb + 0);
        if (((PHMASK >> 1) & 1) && IN(pb + 1)) { LOAD_ARGS(A, kp); WSP(bf16, XB, WS_XB); WSP(float, SS, WS_SS); WSP(bf16, ACT, WS_ACT); const bf16* Wt = (const bf16*)(A.ws + WS_W + (size_t)l * W_LAYER + WO_D1);
            pg8::Gemm g{ACT, Wt, M, D, FF}; pg8::StaticOrder S; S.init(M, D, F.G, bx_l);
            if ((DUP >> 1) & 1) { pg8::EpiResid E1{(l == 0) ? A.x : (const float*)nullptr, XB, SS, 0.25f}; pg8::gemm_phase<pg8::EpiResid, pg8::StaticOrder, RESID_ALIGN, GEMM_SP2, true>(F.lds + RING_OFF, g, S, E1); __syncthreads(); asm volatile("s_waitcnt vmcnt(0)" ::: "memory");
                pg8::EpiResid E2{(const float*)nullptr, XB, SS, 0.25f}; pg8::gemm_phase<pg8::EpiResid, pg8::StaticOrder, RESID_ALIGN, GEMM_SP2, true>(F.lds + RING_OFF, g, S, E2); }
            else { pg8::EpiResid E{(l == 0) ? A.x : (const float*)nullptr, XB, SS, 0.5f}; pg8::gemm_phase<pg8::EpiResid, pg8::StaticOrder, RESID_ALIGN, GEMM_SP2, true>(F.lds + RING_OFF, g, S, E); } }
        SEAM(pb + 1);
        if (((PHMASK >> 2) & 1) && IN(pb + 2)) { LOAD_ARGS(A, kp); WSP(bf16, XB, WS_XB); WSP(float, SS, WS_SS); WSP(bf16, Pb, WS_ACT); WSP(float, PF, WS_PF); const bf16* Wt = (const bf16*)(A.ws + WS_W + (size_t)l * W_LAYER + WO_IN);
            pg8::Gemm g{XB, Wt, M, NP, D}; pg8::StaticOrder S; S.init(M, NP, F.G, bx_l);
            pg8::EpiProj E{Pb, PF, SS, QSCALE, (_Float16*)(A.ws + WS_QIH), (_Float16*)(A.ws + WS_KIH)}; pg8::gemm_phase<pg8::EpiProj, pg8::StaticOrder, true, GEMM_SP2, true>(F.lds + RING_OFF, g, S, E);
            if ((DUP >> 2) & 1) pg8::gemm_phase<pg8::EpiProj, pg8::StaticOrder, true, GEMM_SP2, true>(F.lds + RING_OFF, g, S, E);
            if ((DUP >> 10) & 1) { LimitOrder S1; S1.init(M, NP, F.G, bx_l); S1.lim = 1; pg8::gemm_phase<pg8::EpiProj, LimitOrder, true, true, true>(F.lds + RING_OFF, g, S1, E); }
            if ((DUP >> 11) & 1) { LimitOrder S1; S1.init(M, NP, F.G, bx_l); S1.lim = 2; pg8::gemm_phase<pg8::EpiProj, LimitOrder, true, true, true>(F.lds + RING_OFF, g, S1, E); } }
        SEAM(pb + 2);
        if (((PHMASK >> 3) & 1) && IN(pb + 3)) { prep_phase(F, kp, l); if ((DUP >> 3) & 1) { __syncthreads(); prep_phase(F, kp, l); } }
        SEAM(pb + 3);
        if (((PHMASK >> 4) & 1) && IN(pb + 4)) {
#if EN_SWA == 1
            swa_naive(F, kp, l);
#elif EN_SWA == 2
            swa_phase(F, kp, l);
            if ((DUP >> 4) & 1) swa_phase(F, kp, l);
#endif
#if EN_MOBA == 1
            moba_naive(F, kp);
#elif EN_MOBA == 2
            moba_phase(F, kp);
            if ((DUP >> 5) & 1) moba_phase(F, kp);
#elif EN_MOBA == 3
            moba_bucket_phase(F, kp);
            if ((DUP >> 5) & 1) moba_bucket_phase(F, kp);
#endif
#if EN_DSA == 1
            dsa_naive(F, kp);
#elif EN_DSA == 2
            dsa_phase(F, kp);
            if ((DUP >> 6) & 1) dsa_phase(F, kp);
#endif
        }
        SEAM(pb + 4);
        if (((PHMASK >> 5) & 1) && IN(pb + 5)) { LOAD_ARGS(A, kp); WSP(bf16, XB, WS_XB); WSP(float, SS, WS_SS); WSP(bf16, ATT, WS_ATT); const bf16* Wt = (const bf16*)(A.ws + WS_W + (size_t)l * W_LAYER + WO_OUT);
            pg8::Gemm g{ATT, Wt, M, D, D}; pg8::StaticOrder S; S.init(M, D, F.G, bx_l);
            if ((DUP >> 7) & 1) { pg8::EpiResid E1{(const float*)nullptr, XB, SS, 0.5f}; pg8::gemm_phase<pg8::EpiResid, pg8::StaticOrder, RESID_ALIGN, GEMM_SP2>(F.lds + RING_OFF, g, S, E1); __syncthreads(); asm volatile("s_waitcnt vmcnt(0)" ::: "memory");
                pg8::gemm_phase<pg8::EpiResid, pg8::StaticOrder, RESID_ALIGN, GEMM_SP2>(F.lds + RING_OFF, g, S, E1); }
            else { pg8::EpiResid E{(const float*)nullptr, XB, SS, 1.0f}; pg8::gemm_phase<pg8::EpiResid, pg8::StaticOrder, RESID_ALIGN, GEMM_SP2>(F.lds + RING_OFF, g, S, E); } }
        SEAM(pb + 5);
        if (((PHMASK >> 6) & 1) && IN(pb + 6)) { LOAD_ARGS(A, kp); WSP(bf16, XB, WS_XB); WSP(float, SS, WS_SS); WSP(bf16, ACT, WS_ACT); const bf16* Wt = (const bf16*)(A.ws + WS_W + (size_t)l * W_LAYER + WO_GU2);
            pg8::Gemm g{XB, Wt, M, NGU, D}; pg8::StaticOrder S; S.init(M, NGU, F.G, bx_l);
            pg8::EpiSwiGLU E{ACT, FF, SS}; pg8::gemm_phase<pg8::EpiSwiGLU, pg8::StaticOrder, true, GEMM_SP2, true>(F.lds + RING_OFF, g, S, E); }
        SEAM(pb + 6);
        if (((PHMASK >> 7) & 1) && IN(pb + 7)) { LOAD_ARGS(A, kp); WSP(bf16, XB, WS_XB); WSP(float, SS, WS_SS); WSP(bf16, ACT, WS_ACT); const bf16* Wt = (const bf16*)(A.ws + WS_W + (size_t)l * W_LAYER + WO_D2);
            pg8::Gemm g{ACT, Wt, M, D, FF}; pg8::StaticOrder S; S.init(M, D, F.G, bx_l);
            pg8::EpiResid E{(const float*)nullptr, XB, SS, 0.5f}; pg8::gemm_phase<pg8::EpiResid, pg8::StaticOrder, RESID_ALIGN, GEMM_SP2, true>(F.lds + RING_OFF, g, S, E); }
        SEAM(pb + 7);
    }
#undef IN
#define IN(k) (lo <= (k) && (k) < hi)
    if (((PHMASK >> 9) & 1) && IN(17)) { final_phase(F, kp); }
#undef IN
#undef SEAM
#undef WSP
}
#ifndef MK_ONE_LAUNCH
#define MK_ONE_LAUNCH 1
#endif
extern "C" void kernel_launch(void* const* d_in, const int* in_sizes, int n_in, void* d_out, int out_size, void* d_ws, size_t ws_size, hipStream_t stream) {
    static int grid = 0;
    if (grid == 0) {
        if (n_in != 17 || in_sizes[0] != M * D || out_size != M * D || ws_size < WS_END) { fprintf(stderr, "kernel_launch: unexpected shapes (n_in %d, in0 %d, out %d, ws %zu); nothing launched\n", n_in, n_in > 0 ? in_sizes[0] : -1, out_size, ws_size); grid = -1; return; }
        int dev = 0, cus = 0, per_cu = 0;
        if (hipGetDevice(&dev) != hipSuccess || hipDeviceGetAttribute(&cus, hipDeviceAttributeMultiprocessorCount, dev) != hipSuccess) { grid = -1; return; }
        if (hipFuncSetAttribute((const void*)mega_fwd, hipFuncAttributeMaxDynamicSharedMemorySize, LDS_BYTES) != hipSuccess) { fprintf(stderr, "kernel_launch: hipFuncSetAttribute failed\n"); grid = -1; return; }
        if (hipOccupancyMaxActiveBlocksPerMultiprocessor(&per_cu, (const void*)mega_fwd, NWAVES * 64, LDS_BYTES) != hipSuccess || per_cu < 1) { fprintf(stderr, "kernel_launch: occupancy query reports %d blocks per CU\n", per_cu); }
        (void)hipGetLastError();
        grid = cus;
    }
    if (grid < 0) return;
    if (hipMemsetAsync((char*)d_ws + WS_CTL, 0, CTL_ZERO_BYTES, stream) != hipSuccess) return;
    Args a{};
    a.x = (const float*)d_in[0]; a.rbt = (const float*)d_in[1]; a.n1 = (const float*)d_in[2]; a.g1 = (const float*)d_in[3]; a.u1 = (const float*)d_in[4]; a.d1 = (const float*)d_in[5];
    a.nm = (const float*)d_in[6]; a.win = (const float*)d_in[7]; a.sinks = (const float*)d_in[8]; a.kvn = (const float*)d_in[9]; a.wkv = (const float*)d_in[10]; a.wout = (const float*)d_in[11];
    a.n2 = (const float*)d_in[12]; a.g2 = (const float*)d_in[13]; a.u2 = (const float*)d_in[14]; a.d2 = (const float*)d_in[15]; a.nf = (const float*)d_in[16];
    a.out = (float*)d_out; a.ws = (unsigned char*)d_ws;
#if MK_ONE_LAUNCH
    a.ph_lo = 0; a.ph_hi = N_PHASES;
    hipLaunchKernelGGL(mega_fwd, dim3(grid), dim3(NWAVES * 64), LDS_BYTES, stream, a);
#else
    for (int p = 0; p < N_PHASES; ++p) { a.ph_lo = p; a.ph_hi = p + 1; hipLaunchKernelGGL(mega_fwd, dim3(grid), dim3(NWAVES * 64), LDS_BYTES, stream, a); }
#endif
}
```
